# Optimizing an MI355X kernel written in HIP

```python
import jax, jax.numpy as jnp
from jax import lax
import numpy as np

D_MODEL = 1024
BATCH = 8
SEQ = 4096
DEPTH = 2

N_A = DEPTH // 2
N_B = DEPTH - N_A
HEAD_DIM = 64
N_MAIN_HEADS = 12
MAIN_WIDTH = N_MAIN_HEADS * HEAD_DIM
N_MEM_HEADS = 4
MEM_WIDTH = N_MEM_HEADS * HEAD_DIM
N_MEM = 256
MIX_WIDTH = MAIN_WIDTH + MEM_WIDTH
RET_CHUNK = 128
ROPE_THETA = 10000.0
Q_LORA = 384
KV_LORA = 256
QK_NOPE = 64
QK_ROPE = 32
QK_HEAD = QK_NOPE + QK_ROPE
V_HEAD = 64
Q_BLOCK = 128
N_GROUPS = 4
EXPERTS_PER_GROUP = 8
N_EXPERTS = N_GROUPS * EXPERTS_PER_GROUP
TOP_K = 2
D_EXPERT = 256
MOE_BLOCK = 128
EPS = 1e-6
A_IN_WIDTH = 4 * MAIN_WIDTH + MEM_WIDTH
B_IN_WIDTH = Q_LORA + MEM_WIDTH

kernel_name = "yoco_retention_mla_hier_moe"


def rms_norm(x, g):
    xf = x.astype(jnp.float32)
    y = xf * lax.rsqrt(jnp.mean(xf * xf, axis=-1, keepdims=True) + EPS)
    return (y * g.astype(jnp.float32)).astype(x.dtype)


def rope(x, pos):
    half = x.shape[-1] // 2
    inv = ROPE_THETA ** (-jnp.arange(half, dtype=jnp.float32) / half)
    ang = pos.astype(jnp.float32)[..., None] * inv
    cos = jnp.cos(ang)[:, :, None, :]
    sin = jnp.sin(ang)[:, :, None, :]
    x1 = x[..., :half].astype(jnp.float32)
    x2 = x[..., half:].astype(jnp.float32)
    out = jnp.concatenate([x1 * cos - x2 * sin, x2 * cos + x1 * sin], axis=-1)
    return out.astype(x.dtype)


def retention_chunkwise(q, k, v):
    B, S, H, d = q.shape
    C = RET_CHUNK
    N = S // C
    f32 = jnp.float32
    log_g = jnp.log1p(-jnp.exp2(-5.0 - jnp.arange(H, dtype=f32)))
    qc = q.astype(f32).reshape(B, N, C, H, d)
    kc = k.astype(f32).reshape(B, N, C, H, d) * (d ** -0.5)
    vc = v.astype(f32).reshape(B, N, C, H, d)
    idx = jnp.arange(C, dtype=f32)
    rel = idx[:, None] - idx[None, :]
    decay_in = jnp.where(rel[None] >= 0,
                         jnp.exp(log_g[:, None, None] * jnp.maximum(rel, 0.0)[None]), 0.0)
    scores = jnp.einsum('bnihd,bnjhd->bnhij', qc, kc) * decay_in
    inner = jnp.einsum('bnhij,bnjhe->bnihe', scores, vc)
    k_dec = kc * jnp.exp(log_g[None, :] * (C - 1.0 - idx)[:, None])[:, :, None]
    U = jnp.einsum('bnjhd,bnjhe->nbhde', k_dec, vc)
    chunk_decay = jnp.exp(log_g * C)[None, :, None, None]

    def step(R, u):
        return chunk_decay * R + u, R

    _, R_prev = lax.scan(step, jnp.zeros((B, H, d, d), f32), U)
    q_dec = qc * jnp.exp(log_g[None, :] * (idx + 1.0)[:, None])[:, :, None]
    cross = jnp.einsum('bnihd,nbhde->bnihe', q_dec, R_prev)
    return (inner + cross).reshape(B, S, H, d)


def head_group_norm(y, g):
    B, S, H, d = y.shape
    mu = jnp.mean(y, axis=-1, keepdims=True)
    yc = y - mu
    var = jnp.mean(yc * yc, axis=-1, keepdims=True)
    return (yc * lax.rsqrt(var + EPS)).reshape(B, S, H * d) * g.astype(jnp.float32)


def memory_attention(qm, mem, w_mem_kv, q_g, k_g):
    B, S, _ = qm.shape
    M = mem.shape[1]
    q = rms_norm(qm.reshape(B, S, N_MEM_HEADS, HEAD_DIM), q_g)
    kv = mem @ w_mem_kv
    k = rms_norm(kv[..., :MEM_WIDTH].reshape(B, M, N_MEM_HEADS, HEAD_DIM), k_g)
    v = kv[..., MEM_WIDTH:].reshape(B, M, N_MEM_HEADS, HEAD_DIM)
    s = jnp.einsum('bshd,bmhd->bhsm', q, k).astype(jnp.float32) * (HEAD_DIM ** -0.5)
    p = jax.nn.softmax(s, axis=-1).astype(v.dtype)
    o = jnp.einsum('bhsm,bmhd->bshd', p, v)
    return o.reshape(B, S, MEM_WIDTH)


def shared_latent_kv(x, kv_ln, w_dkv, kv_lora_g, w_ukv, k_g, pos):
    B, S, _ = x.shape
    h = rms_norm(x, kv_ln)
    ckr = h @ w_dkv
    c_kv = rms_norm(ckr[..., :KV_LORA], kv_lora_g)
    k_rope = ckr[..., KV_LORA:]
    kv = (c_kv @ w_ukv).reshape(B, S, N_MAIN_HEADS, QK_NOPE + V_HEAD)
    k_nope = kv[..., :QK_NOPE]
    v = kv[..., QK_NOPE:]
    k = jnp.concatenate(
        [k_nope, jnp.broadcast_to(k_rope[:, :, None, :], (B, S, N_MAIN_HEADS, QK_ROPE))], axis=-1)
    k = rms_norm(k, k_g)
    k = jnp.concatenate([k[..., :QK_NOPE], rope(k[..., QK_NOPE:], pos)], axis=-1)
    return k, v


def mla_attention(c_q, q_lora_g, w_uq, q_g, k, v, pos):
    B, S, _ = c_q.shape
    q = (rms_norm(c_q, q_lora_g) @ w_uq).reshape(B, S, N_MAIN_HEADS, QK_HEAD)
    q = rms_norm(q, q_g)
    q = jnp.concatenate([q[..., :QK_NOPE], rope(q[..., QK_NOPE:], pos)], axis=-1)
    nb = S // Q_BLOCK
    qb = q.reshape(B, nb, Q_BLOCK, N_MAIN_HEADS, QK_HEAD).transpose(1, 0, 2, 3, 4)
    k_idx = jnp.arange(S)
    scale = QK_HEAD ** -0.5

    def block(args):
        qi, bi = args
        s = jnp.einsum('bqhd,bkhd->bhqk', qi, k).astype(jnp.float32) * scale
        q_idx = bi * Q_BLOCK + jnp.arange(Q_BLOCK)
        s = jnp.where(k_idx[None, :] <= q_idx[:, None], s, -jnp.inf)
        p = jax.nn.softmax(s, axis=-1).astype(v.dtype)
        return jnp.einsum('bhqk,bkhd->bqhd', p, v)

    o = lax.map(block, (qb, jnp.arange(nb)))
    return o.transpose(1, 0, 2, 3, 4).reshape(B, S, N_MAIN_HEADS * V_HEAD)


def hier_moe(h, w_grp, b_grp, w_exp, b_exp, w_gate, w_up, w_down):
    B, S, D = h.shape
    T = B * S
    xf = h.reshape(T, D)
    g_prob = jax.nn.softmax((xf @ w_grp).astype(jnp.float32) + b_grp.astype(jnp.float32), axis=-1)
    grp = jnp.argmax(g_prob, axis=-1)
    p_grp = jnp.max(g_prob, axis=-1, keepdims=True)
    e_logits = ((xf @ w_exp).astype(jnp.float32) + b_exp.astype(jnp.float32)).reshape(
        T, N_GROUPS, EXPERTS_PER_GROUP)
    e_logits = e_logits[jnp.arange(T), grp]
    e_prob = jax.nn.softmax(e_logits, axis=-1)
    top_p, top_i = lax.top_k(e_prob, TOP_K)
    gate = p_grp * top_p / jnp.sum(top_p, axis=-1, keepdims=True)
    expert = grp[:, None] * EXPERTS_PER_GROUP + top_i
    A = T * TOP_K
    flat_e = expert.reshape(A).astype(jnp.int32)
    flat_tok = jnp.repeat(jnp.arange(T, dtype=jnp.int32), TOP_K)
    flat_w = gate.reshape(A)
    order = jnp.argsort(flat_e)
    sorted_e = flat_e[order]
    counts = jnp.zeros((N_EXPERTS,), jnp.int32).at[flat_e].add(1)
    padded = (counts + MOE_BLOCK - 1) // MOE_BLOCK * MOE_BLOCK
    pad_end = jnp.cumsum(padded)
    pad_start = pad_end - padded
    start = jnp.cumsum(counts) - counts
    dest = pad_start[sorted_e] + (jnp.arange(A, dtype=jnp.int32) - start[sorted_e])
    P = A + N_EXPERTS * MOE_BLOCK
    row_tok = jnp.zeros((P,), jnp.int32).at[dest].set(flat_tok[order])
    row_w = jnp.zeros((P,), jnp.float32).at[dest].set(flat_w[order])
    nblk = P // MOE_BLOCK
    blk_e = jnp.minimum(
        jnp.searchsorted(pad_end, jnp.arange(nblk, dtype=jnp.int32) * MOE_BLOCK, side='right'),
        N_EXPERTS - 1)
    xs = xf[row_tok].reshape(nblk, MOE_BLOCK, D)

    def expert_block(args):
        xb, e = args
        hid = jax.nn.silu(xb @ w_gate[e]) * (xb @ w_up[e])
        return hid @ w_down[e]

    ys = lax.map(expert_block, (xs, blk_e)).reshape(P, D)
    out = jax.ops.segment_sum(ys.astype(jnp.float32) * row_w[:, None], row_tok, num_segments=T)
    return out.astype(h.dtype).reshape(B, S, D)


def retention_mixer(x, pos, mem, ln1, w_in, ret_gn, w_mem_kv, mq_g, mk_g, w_out):
    B, S, _ = x.shape
    h = rms_norm(x, ln1)
    proj = h @ w_in
    q, k, v, g, qm = jnp.split(proj, [MAIN_WIDTH, 2 * MAIN_WIDTH, 3 * MAIN_WIDTH, 4 * MAIN_WIDTH], axis=-1)
    q = rope(q.reshape(B, S, N_MAIN_HEADS, HEAD_DIM), pos)
    k = rope(k.reshape(B, S, N_MAIN_HEADS, HEAD_DIM), pos)
    v = v.reshape(B, S, N_MAIN_HEADS, HEAD_DIM)
    y = head_group_norm(retention_chunkwise(q, k, v), ret_gn)
    y = (jax.nn.silu(g.astype(jnp.float32)) * y).astype(x.dtype)
    m = memory_attention(qm, mem, w_mem_kv, mq_g, mk_g)
    return x + jnp.concatenate([y, m], axis=-1) @ w_out


def mla_mixer(x, pos, mem, k_sh, v_sh, ln1, w_in, q_lora_g, w_uq, q_g, w_mem_kv, mq_g, mk_g, w_out):
    h = rms_norm(x, ln1)
    proj = h @ w_in
    c_q, qm = proj[..., :Q_LORA], proj[..., Q_LORA:]
    y = mla_attention(c_q, q_lora_g, w_uq, q_g, k_sh, v_sh, pos)
    m = memory_attention(qm, mem, w_mem_kv, mq_g, mk_g)
    return x + jnp.concatenate([y, m], axis=-1) @ w_out


def setup_inputs(seed: int = 0) -> dict:
    key = jax.random.key(seed)
    ks = iter(jax.random.split(key, 40))
    f32 = jnp.float32

    def nrm(shape, fan_in):
        return jax.random.normal(next(ks), shape, f32) * (fan_in ** -0.5)

    def gain(shape):
        return 1.0 + 0.02 * jax.random.normal(next(ks), shape, f32)

    def bias(shape):
        return 0.01 * jax.random.normal(next(ks), shape, f32)

    x = jax.random.normal(next(ks), (BATCH, SEQ, D_MODEL), f32)
    mem = jax.random.normal(next(ks), (BATCH, N_MEM, D_MODEL), f32)
    offs = jax.random.randint(next(ks), (BATCH, 1), 0, 2048, dtype=jnp.int32)
    positions = offs + jnp.arange(SEQ, dtype=jnp.int32)[None, :]
    return {
        "x": x, "mem": mem, "positions": positions,
        "ln1": gain((DEPTH, D_MODEL)),
        "ln2": gain((DEPTH, D_MODEL)),
        "w_out": nrm((DEPTH, MIX_WIDTH, D_MODEL), MIX_WIDTH),
        "mem_w_kv": nrm((DEPTH, D_MODEL, 2 * MEM_WIDTH), D_MODEL),
        "mem_q_norm": gain((DEPTH, HEAD_DIM)),
        "mem_k_norm": gain((DEPTH, HEAD_DIM)),
        "router_group_w": nrm((DEPTH, D_MODEL, N_GROUPS), D_MODEL),
        "router_group_b": bias((DEPTH, N_GROUPS)),
        "router_expert_w": nrm((DEPTH, D_MODEL, N_EXPERTS), D_MODEL),
        "router_expert_b": bias((DEPTH, N_EXPERTS)),
        "expert_w_gate": nrm((DEPTH, N_EXPERTS, D_MODEL, D_EXPERT), D_MODEL),
        "expert_w_up": nrm((DEPTH, N_EXPERTS, D_MODEL, D_EXPERT), D_MODEL),
        "expert_w_down": nrm((DEPTH, N_EXPERTS, D_EXPERT, D_MODEL), D_EXPERT),
        "ret_w_in": nrm((N_A, D_MODEL, A_IN_WIDTH), D_MODEL),
        "ret_gn": gain((N_A, MAIN_WIDTH)),
        "kv_ln": gain((D_MODEL,)),
        "kv_w_down": nrm((D_MODEL, KV_LORA + QK_ROPE), D_MODEL),
        "kv_lora_norm": gain((KV_LORA,)),
        "kv_w_up": nrm((KV_LORA, N_MAIN_HEADS * (QK_NOPE + V_HEAD)), KV_LORA),
        "k_norm": gain((QK_HEAD,)),
        "mla_w_in": nrm((N_B, D_MODEL, B_IN_WIDTH), D_MODEL),
        "q_lora_norm": gain((N_B, Q_LORA)),
        "mla_w_uq": nrm((N_B, Q_LORA, N_MAIN_HEADS * QK_HEAD), Q_LORA),
        "q_norm": gain((N_B, QK_HEAD)),
    }


def reference(x, mem, positions, ln1, ln2, w_out, mem_w_kv, mem_q_norm, mem_k_norm,
              router_group_w, router_group_b, router_expert_w, router_expert_b,
              expert_w_gate, expert_w_up, expert_w_down, ret_w_in, ret_gn,
              kv_ln, kv_w_down, kv_lora_norm, kv_w_up, k_norm,
              mla_w_in, q_lora_norm, mla_w_uq, q_norm):
    k_sh = None
    v_sh = None
    for i in range(DEPTH):
        if i < N_A:
            x = retention_mixer(x, positions, mem, ln1[i], ret_w_in[i], ret_gn[i],
                                mem_w_kv[i], mem_q_norm[i], mem_k_norm[i], w_out[i])
        else:
            j = i - N_A
            x = mla_mixer(x, positions, mem, k_sh, v_sh, ln1[i], mla_w_in[j], q_lora_norm[j],
                          mla_w_uq[j], q_norm[j], mem_w_kv[i], mem_q_norm[i], mem_k_norm[i], w_out[i])
        x = x + hier_moe(rms_norm(x, ln2[i]), router_group_w[i], router_group_b[i],
                         router_expert_w[i], router_expert_b[i],
                         expert_w_gate[i], expert_w_up[i], expert_w_down[i])
        if i == N_A - 1:
            k_sh, v_sh = shared_latent_kv(x, kv_ln, kv_w_down, kv_lora_norm, kv_w_up, k_norm, positions)
    return x
```

```cpp
#include <hip/hip_runtime.h>
#include <cstdio>
#include <cstdint>

#define GAS __attribute__((address_space(1)))
#define LAS __attribute__((address_space(3)))
typedef unsigned short bf16_t;
typedef short bf16x8 __attribute__((ext_vector_type(8)));
typedef short s16x4 __attribute__((ext_vector_type(4)));
typedef float f32x4 __attribute__((ext_vector_type(4)));
typedef float f32x16 __attribute__((ext_vector_type(16)));
typedef float f32x2 __attribute__((ext_vector_type(2)));
typedef unsigned u32x4 __attribute__((ext_vector_type(4)));
typedef unsigned u32x2 __attribute__((ext_vector_type(2)));

constexpr int D = 1024, NB = 8, SEQ = 4096, T = NB * SEQ;
constexpr int NH = 12, HD = 64, MAINW = 768, MEMW = 256, NMEM = 256;
constexpr int A_IN = 4 * MAINW + MEMW;
constexpr int QL = 384, KVL = 256, QKH = 96, ROPED = 32;
constexpr int NE = 32, DE = 256;
constexpr int RCH = 128, NCH = SEQ / RCH;
constexpr float EPS = 1e-6f;
constexpr int PMAX = 2 * T + NE * 256;
constexpr int LDQ = 1280, LDKV = 1536;

constexpr size_t MiB = 1u << 20;
constexpr size_t WS_CTL = 0, CTL_ZERO_BYTES = 1 * MiB;
constexpr size_t WS_WIN0 = 1 * MiB;
constexpr size_t WS_WOUT = WS_WIN0 + (size_t)A_IN * D * 2;
constexpr size_t WS_WMKV = WS_WOUT + (size_t)2 * D * D * 2;
constexpr size_t WS_WIN1 = WS_WMKV + (size_t)D * D * 2;
constexpr size_t WS_WUKV = WS_WIN1 + (size_t)D * D * 2;
constexpr size_t WS_WUQ = WS_WUKV + (size_t)1536 * 256 * 2;
constexpr size_t WS_WR = WS_WUQ + (size_t)1280 * 384 * 2;
constexpr size_t WS_BR = WS_WR + (size_t)2 * 2 * 36 * 1024 * 2;
constexpr size_t WS_RS0 = WS_BR + 4096;
constexpr size_t WS_TKER = WS_RS0 + (size_t)4 * T * 4;
constexpr size_t WS_TKW = WS_TKER + (size_t)2 * T * 2 * 4;
constexpr size_t WS_SMALL_END = WS_TKW + (size_t)2 * T * 2 * 4;
static_assert(WS_SMALL_END <= 20 * MiB, "small region");
constexpr size_t WS_CS64 = 20 * MiB;
constexpr size_t WS_CS32 = 28 * MiB;
constexpr size_t WS_WEXP = 32 * MiB;
constexpr size_t WEXP_L = 48 * MiB, WEXP_DN = 32 * MiB;
constexpr size_t WS_MEMB = 128 * MiB;
constexpr size_t WS_KVM = 132 * MiB;
constexpr size_t WS_LIST = 136 * MiB;
constexpr size_t WS_XA = 144 * MiB;
constexpr size_t WS_BIG = 208 * MiB;
constexpr size_t WS_PROJ0 = WS_BIG;
constexpr size_t WS_UT = WS_BIG + 208 * MiB;
constexpr size_t WS_RT = WS_UT + 48 * MiB;
constexpr size_t WS_HID = WS_BIG;
constexpr size_t WS_YS = WS_BIG + 36 * MiB;
constexpr size_t WS_PROJ1 = WS_BIG;
constexpr size_t WS_KV = WS_BIG + 64 * MiB;
constexpr size_t WS_Q = WS_KV + 96 * MiB;
constexpr size_t WS_VT = WS_Q + 80 * MiB;
constexpr size_t WS_END = 512 * MiB;
static_assert(WS_RT + 24 * MiB <= WS_END && WS_VT + 48 * MiB <= WS_END && WS_YS + (size_t)PMAX * 1024 * 2 <= WS_END && (size_t)PMAX * 256 * 2 <= 36 * MiB, "ws map");
constexpr int CW_CNT = 64;
constexpr int CW_BAR = 4096;

constexpr int LDS_BYTES = 163840;
constexpr int L_MISC = 131072;
constexpr int L_BARW = LDS_BYTES - 16;

#define RLX_AGENT __ATOMIC_RELAXED, __HIP_MEMORY_SCOPE_AGENT
#define LDS_WAIT() asm volatile("s_waitcnt lgkmcnt(0)" ::: "memory")
#define VM_WAIT() asm volatile("s_waitcnt vmcnt(0)" ::: "memory")
__device__ __forceinline__ unsigned f2bf(float f) { unsigned u = __builtin_bit_cast(unsigned, f); return (u + 0x7fffu + ((u >> 16) & 1u)) >> 16; }
__device__ __forceinline__ unsigned pk2(float lo, float hi) { return f2bf(lo) | (f2bf(hi) << 16); }
__device__ __forceinline__ float bf2f(unsigned short b) { return __builtin_bit_cast(float, (unsigned)b << 16); }
__device__ __forceinline__ float bflo(unsigned w) { return __builtin_bit_cast(float, w << 16); }
__device__ __forceinline__ float bfhi(unsigned w) { return __builtin_bit_cast(float, w & 0xffff0000u); }
__device__ __forceinline__ float wave_sum(float v) {
#pragma unroll
    for (int o = 1; o < 64; o <<= 1) v += __shfl_xor(v, o);
    return v;
}
__device__ __forceinline__ float siluf(float a) { return a / (1.f + __expf(-a)); }
#define MFMA16(a, b, c) __builtin_amdgcn_mfma_f32_16x16x32_bf16((a), (b), (c), 0, 0, 0)
#define MFMA32(a, b, c) __builtin_amdgcn_mfma_f32_32x32x16_bf16((a), (b), (c), 0, 0, 0)

#define XB_TMO      128
#define XB_XCNT(j)  (256  + 64 * (j))
#define XB_XSUB(j)  (1280 + 64 * (j))
#define XB_XGEN(j)  (2304 + 64 * (j))
#define XB_TOP      3328
#define XB_TOPGEN   3392
#define XCD_BAR_WORDS 3456
#define XB_SPIN_CAP (1u << 18)
__device__ __forceinline__ unsigned xb_ld(unsigned* p)              { return __hip_atomic_load(p, __ATOMIC_RELAXED, __HIP_MEMORY_SCOPE_AGENT); }
__device__ __forceinline__ unsigned xb_add(unsigned* p, unsigned v) { return __hip_atomic_fetch_add(p, v, __ATOMIC_RELAXED, __HIP_MEMORY_SCOPE_AGENT); }
__device__ __forceinline__ unsigned xb_xcc_id() { return (unsigned)__builtin_amdgcn_s_getreg((3 << 11) | 20) & 0xFu; }
#define XB_SPIN(cond, bar) do { unsigned _sp = 0; while (cond) { __builtin_amdgcn_s_sleep(1); \
    if ((++_sp & 255u) == 0u) { if (xb_ld(&(bar)[XB_TMO])) break; if (_sp > XB_SPIN_CAP) { atomicAdd(&(bar)[XB_TMO], 1u); break; } } } } while (0)
struct XcdBarrier { unsigned* bar; unsigned x; volatile LAS unsigned* st; };
__device__ __forceinline__ XcdBarrier xcd_barrier_post(unsigned* bar, volatile LAS unsigned* st) {
    XcdBarrier b; b.bar = bar; b.x = xb_xcc_id(); b.st = st;
    if (threadIdx.x == 0) (void)xb_add(&bar[XB_XCNT(b.x)], 1u);
    return b;
}
__device__ __forceinline__ void xcd_barrier_complete(unsigned* bar, unsigned x, unsigned& nloc, unsigned& nx) {
    const unsigned G = gridDim.x * gridDim.y * gridDim.z;
    unsigned sum, cnt, mine, sp = 0u;
    for (;;) {
        sum = 0u; cnt = 0u; mine = 0u;
#pragma unroll
        for (unsigned j = 0; j < 16; ++j) { const unsigned c = xb_ld(&bar[XB_XCNT(j)]); sum += c; cnt += (c > 0u) ? 1u : 0u; mine = (j == x) ? c : mine; }
        if (sum == G) break;
        __builtin_amdgcn_s_sleep(1);
        if ((++sp & 255u) == 0u) { if (xb_ld(&bar[XB_TMO])) break; if (sp > XB_SPIN_CAP) { atomicAdd(&bar[XB_TMO], 1u); break; } }
    }
    nloc = mine > 0u ? mine : 1u; nx = cnt > 0u ? cnt : 1u;
}
__device__ __forceinline__ void xcd_barrier(const XcdBarrier& b) {
    asm volatile("s_waitcnt vmcnt(0)" ::: "memory");
    __syncthreads();
    if (threadIdx.x == 0) {
        unsigned* bar = b.bar;
        __builtin_amdgcn_s_waitcnt(0);
        unsigned nloc = b.st[0], nx = b.st[1];
        if (nloc == 0u) { xcd_barrier_complete(bar, b.x, nloc, nx); b.st[0] = nloc; b.st[1] = nx; }
        const unsigned old = xb_add(&bar[XB_XSUB(b.x)], 1u);
        const unsigned gen = old / nloc;
        if (old + 1u == (gen + 1u) * nloc) {
            __builtin_amdgcn_fence(__ATOMIC_RELEASE, "agent");
            asm volatile("s_waitcnt vmcnt(0)" ::: "memory");
            const unsigned og = xb_add(&bar[XB_TOP], 1u);
            const unsigned tg = og / nx;
            if (og + 1u == (tg + 1u) * nx) xb_add(&bar[XB_TOPGEN], 1u);
            else XB_SPIN(xb_ld(&bar[XB_TOPGEN]) == tg, bar);
            __builtin_amdgcn_fence(__ATOMIC_ACQUIRE, "agent");
            xb_add(&bar[XB_XGEN(b.x)], 1u);
            asm volatile("s_waitcnt vmcnt(0)" ::: "memory");
        } else {
            XB_SPIN(xb_ld(&bar[XB_XGEN(b.x)]) == gen, bar);
            __builtin_amdgcn_fence(__ATOMIC_ACQUIRE, "agent");
            asm volatile("s_waitcnt vmcnt(0)" ::: "memory");
        }
    }
    __syncthreads();
}

namespace pg8 {
constexpr int BM = 256, BK = 64, HALF = 128, HTB = HALF * BK * 2, STAGE_BYTES = 8 * HTB, NXCD = 8, WGM = 8;
__host__ __device__ __forceinline__ int lds_byte(int r, int c) { const int st = (r >> 4) * 2 + (c >> 5), rr = r & 15, cc = c & 31, ob = rr * 64 + cc * 2; return st * 1024 + (ob ^ (((ob >> 9) & 1) << 5)); }
__host__ __device__ __forceinline__ void stage_rc(int b, int& R, int& C) { const int st = b / 1024, sb = b % 1024, swz = sb ^ (((sb >> 9) & 1) << 5); R = (st >> 1) * 16 + swz / 64; C = (st & 1) * 32 + (swz % 64) / 2; }
__host__ __device__ __forceinline__ int perm32(int rho) { const int n = rho >> 4, i = rho & 15; return 8 * (i >> 2) + 4 * n + (i & 3); }
struct Unit { int pm, pn, ord; };
struct Gemm { const bf16_t* A; const bf16_t* Bt; int lda, ldb, K; };
struct StaticOrder {
    int nM, nN, nwg, G, c;
    __device__ void init(int M, int N, int G_, int c_) { nM = M / BM; nN = N / BM; nwg = nM * nN; G = G_; c = c_; }
    __device__ bool next(int i, Unit& u) const {
        const long L = (long)i * G + c; if (L >= nwg) return false;
        int wgid = (int)L; { const int q = nwg / NXCD, r = nwg % NXCD, xcd = wgid % NXCD, off = wgid / NXCD; wgid = (xcd < r ? xcd * (q + 1) : r * (q + 1) + (xcd - r) * q) + off; }
        const int nig = WGM * nN, gid = wgid / nig, fm = gid * WGM, gsz = (nM - fm) < WGM ? (nM - fm) : WGM;
        u.pm = fm + ((wgid % nig) % gsz); u.pn = (wgid % nig) / gsz; u.ord = i; return true;
    }
};
struct MoeOrder {
    const LAS int* tb; int nNe, G, c;
    __device__ bool next(int i, Unit& u) const {
        const int L = i * G + c; const int NT = tb[32]; if (L >= NT * nNe) return false;
        const int rtg = L / nNe, pn = L % nNe; int e = 0; while (tb[e + 1] <= rtg) ++e;
        u.pm = rtg; u.pn = e * nNe + pn; u.ord = i; return true;
    }
};
__device__ __forceinline__ unsigned cvt_pk_bf16(float lo, float hi) { typedef __bf16 b2 __attribute__((ext_vector_type(2))); f32x2 v = {lo, hi}; b2 b = __builtin_convertvector(v, b2); return __builtin_bit_cast(unsigned, b); }

struct EpiBf16S {
    static constexpr bool PERM = true;
    bf16_t* O; int ldc; const float* rs; int pnmod;
    __device__ __forceinline__ void operator()(const f32x4 (&acc)[2][2][4][2], const Unit& u, int wr, int wc, int fr, int fq) const {
        const int row0 = u.pm * BM + wr * 64 + fr; const int pn = pnmod ? (u.pn % pnmod) : u.pn; const int col0 = pn * BM + wc * 32 + 8 * fq;
#pragma unroll
        for (int ai = 0; ai < 2; ++ai)
#pragma unroll
            for (int m = 0; m < 4; ++m) { const int row = row0 + ai * HALF + m * 16; const float s = rs ? rs[row] : 1.f; bf16_t* rowp = O + (size_t)row * ldc + col0;
#pragma unroll
                for (int bj = 0; bj < 2; ++bj) { const f32x4 v0 = acc[ai][bj][m][0] * s, v1 = acc[ai][bj][m][1] * s;
                    u32x4 w; w.x = cvt_pk_bf16(v0[0], v0[1]); w.y = cvt_pk_bf16(v0[2], v0[3]); w.z = cvt_pk_bf16(v1[0], v1[1]); w.w = cvt_pk_bf16(v1[2], v1[3]);
                    *(u32x4*)(rowp + bj * HALF) = w; } }
    }
};
struct EpiSwiGLU {
    static constexpr bool PERM = true;
    bf16_t* O; const LAS float* rsL;
    __device__ __forceinline__ void operator()(const f32x4 (&acc)[2][2][4][2], const Unit& u, int wr, int wc, int fr, int fq) const {
        const int col0 = (u.pn & 1) * HALF + wc * 32 + 8 * fq;
#pragma unroll
        for (int ai = 0; ai < 2; ++ai)
#pragma unroll
            for (int m = 0; m < 4; ++m) { const int lr = ai * HALF + wr * 64 + m * 16 + fr; const float s = rsL[u.ord * 256 + lr]; bf16_t* rowp = O + (size_t)(u.pm * BM + lr) * 256 + col0;
                float h[8];
#pragma unroll
                for (int n = 0; n < 2; ++n)
#pragma unroll
                    for (int j = 0; j < 4; ++j) { const float g = acc[ai][0][m][n][j] * s, up = acc[ai][1][m][n][j] * s; h[n * 4 + j] = siluf(g) * up; }
                u32x4 w; w.x = cvt_pk_bf16(h[0], h[1]); w.y = cvt_pk_bf16(h[2], h[3]); w.z = cvt_pk_bf16(h[4], h[5]); w.w = cvt_pk_bf16(h[6], h[7]);
                *(u32x4*)rowp = w; }
    }
};
struct EpiF32Res {
    static constexpr bool PERM = false;
    float* C; const float* R; int ldc;
    __device__ __forceinline__ void operator()(const f32x4 (&acc)[2][2][4][2], const Unit& u, int wr, int wc, int fr, int fq) const {
        const int row0 = u.pm * BM + wr * 64 + fr, col0 = u.pn * BM + wc * 32 + 4 * fq;
#pragma unroll
        for (int ai = 0; ai < 2; ++ai)
#pragma unroll
            for (int m = 0; m < 4; ++m) { const size_t off = (size_t)(row0 + ai * HALF + m * 16) * ldc + col0;
#pragma unroll
                for (int bj = 0; bj < 2; ++bj)
#pragma unroll
                    for (int n = 0; n < 2; ++n) { const f32x4 r = *(const f32x4*)(R + off + bj * HALF + n * 16); *(f32x4*)(C + off + bj * HALF + n * 16) = acc[ai][bj][m][n] + r; } }
    }
};

template <class Epi, class Sched, bool GATHER>
__device__ __forceinline__ void gemm_phase(LAS unsigned char* lds, const Gemm g, const Sched& S, const Epi& E, const LAS int* tokL) {
    const int tid = threadIdx.x, wid = __builtin_amdgcn_readfirstlane(tid >> 6), lane = tid & 63, wr = wid >> 2, wc = wid & 3, fr = lane & 15, fq = lane >> 4;
    const int K = g.K, nt = K / BK;
    unsigned voffA[2], voffB[2]; int RA[2], CA[2];
#pragma unroll
    for (int i = 0; i < 2; ++i) { int R, C; stage_rc(tid * 16 + i * 8192, R, C); const int Rb = Epi::PERM ? ((R & ~31) + perm32(R & 31)) : R; RA[i] = R; CA[i] = C;
        voffA[i] = (unsigned)(R * g.lda + C) * 2u; voffB[i] = (unsigned)(Rb * g.ldb + C) * 2u; }
    const size_t kstep = (size_t)(BK * 2);
    const size_t hstepA = GATHER ? 0 : (size_t)HALF * g.lda * 2, hstepB = (size_t)HALF * g.ldb * 2;
    const size_t tstepA = 2 * (size_t)HALF * g.lda * 2, tstepB = 2 * hstepB;
    const unsigned ldsw = (unsigned)wid * 1024u;
    const int aoff = lds_byte(wr * 64 + fr, fq * 8), boff = lds_byte(wc * 32 + fr, fq * 8);
#define PG8_SA(b, h) (((b) * 2 + (h)) * HTB)
#define PG8_SB(b, h) ((4 + (b) * 2 + (h)) * HTB)
#define PG8_STAGE(bufoff, gbase, voff) do { _Pragma("unroll") for (int _i = 0; _i < 2; ++_i) \
        __builtin_amdgcn_global_load_lds((const unsigned*)((const char*)(gbase) + (voff)[_i]), (LAS unsigned*)(lds + (bufoff) + ldsw + _i * 8192), 16, 0, 0); } while (0)
#define PG8_LDA(dst, b, h) do { _Pragma("unroll") for (int m = 0; m < 4; ++m) _Pragma("unroll") for (int k = 0; k < 2; ++k) dst[m][k] = *(const LAS bf16x8*)(lds + PG8_SA(b, h) + aoff + m * 2048 + k * 1024); } while (0)
#define PG8_LDB(dst, b, h) do { _Pragma("unroll") for (int n = 0; n < 2; ++n) _Pragma("unroll") for (int k = 0; k < 2; ++k) dst[n][k] = *(const LAS bf16x8*)(lds + PG8_SB(b, h) + boff + n * 2048 + k * 1024); } while (0)
#define PG8_MMA(ai, bj, At, Bt) do { __builtin_amdgcn_s_setprio(1); _Pragma("unroll") for (int m = 0; m < 4; ++m) _Pragma("unroll") for (int n = 0; n < 2; ++n) _Pragma("unroll") for (int k = 0; k < 2; ++k) \
        acc[ai][bj][m][n] = __builtin_amdgcn_mfma_f32_16x16x32_bf16(Bt[n][k], At[m][k], acc[ai][bj][m][n], 0, 0, 0); __builtin_amdgcn_s_setprio(0); } while (0)
#define PG8_WAIT_V(n) asm volatile("s_waitcnt vmcnt(" #n ")" ::: "memory")
#define PG8_WAIT_L(n) asm volatile("s_waitcnt lgkmcnt(" #n ")" ::: "memory")
#define PG8_BAR __builtin_amdgcn_s_barrier()
#define PG8_SCHED __builtin_amdgcn_sched_barrier(0)
    Unit cur, nxt; int ui = 0;
    if (!S.next(0, cur)) return;
    f32x4 acc[2][2][4][2];
#pragma unroll
    for (int a = 0; a < 2; ++a)
#pragma unroll
        for (int b = 0; b < 2; ++b)
#pragma unroll
            for (int m = 0; m < 4; ++m)
#pragma unroll
                for (int n = 0; n < 2; ++n) acc[a][b][m][n] = (f32x4){0.f, 0.f, 0.f, 0.f};
    bf16x8 At[4][2], B0[2][2], B1[2][2];
    unsigned cv0[2], cv1[2], nv0[2], nv1[2];
    if constexpr (GATHER) {
#pragma unroll
        for (int i = 0; i < 2; ++i) { cv0[i] = (unsigned)(tokL[cur.ord * 256 + RA[i]] * g.lda + CA[i]) * 2u; cv1[i] = (unsigned)(tokL[cur.ord * 256 + HALF + RA[i]] * g.lda + CA[i]) * 2u; nv0[i] = cv0[i]; nv1[i] = cv1[i]; }
    } else {
#pragma unroll
        for (int i = 0; i < 2; ++i) { cv0[i] = voffA[i]; cv1[i] = voffA[i]; nv0[i] = voffA[i]; nv1[i] = voffA[i]; }
    }
    const char* cA = (const char*)g.A + (GATHER ? (size_t)0 : (size_t)cur.pm * tstepA); const char* cB = (const char*)g.Bt + (size_t)cur.pn * tstepB;
    PG8_STAGE(PG8_SB(0, 0), cB, voffB); PG8_STAGE(PG8_SB(0, 1), cB + hstepB, voffB); PG8_STAGE(PG8_SA(0, 0), cA, cv0); PG8_STAGE(PG8_SA(0, 1), cA + hstepA, cv1);
    if (wr == 1) PG8_BAR;
    PG8_WAIT_V(2); PG8_BAR;
    PG8_STAGE(PG8_SB(1, 0), cB + kstep, voffB); PG8_STAGE(PG8_SA(1, 0), cA + kstep, cv0); PG8_STAGE(PG8_SB(1, 1), cB + hstepB + kstep, voffB);
    PG8_WAIT_V(6); PG8_BAR;
    for (;;) {
        const bool has_next = S.next(ui + 1, nxt);
        const char* nA = has_next ? (const char*)g.A + (GATHER ? (size_t)0 : (size_t)nxt.pm * tstepA) : cA; const char* nB = has_next ? (const char*)g.Bt + (size_t)nxt.pn * tstepB : cB;
        if constexpr (GATHER) { if (has_next) {
#pragma unroll
            for (int i = 0; i < 2; ++i) { nv0[i] = (unsigned)(tokL[nxt.ord * 256 + RA[i]] * g.lda + CA[i]) * 2u; nv1[i] = (unsigned)(tokL[nxt.ord * 256 + HALF + RA[i]] * g.lda + CA[i]) * 2u; } } }
#pragma unroll 1
        for (int t = 0; t < nt; t += 2) {
            const bool last = (t == nt - 2);
            const char* a1 = cA + (size_t)(t + 1) * kstep;
            const char* a2 = last ? nA : cA + (size_t)(t + 2) * kstep; const char* b2 = last ? nB : cB + (size_t)(t + 2) * kstep;
            const char* a3 = a2 + kstep; const char* b3 = b2 + kstep;
            unsigned w0[2], w1[2];
#pragma unroll
            for (int i = 0; i < 2; ++i) { w0[i] = last ? nv0[i] : cv0[i]; w1[i] = last ? nv1[i] : cv1[i]; }
            PG8_LDB(B0, 0, 0); PG8_LDB(B1, 0, 1); PG8_SCHED; PG8_LDA(At, 0, 0); PG8_STAGE(PG8_SA(1, 1), a1 + hstepA, cv1);
            PG8_WAIT_V(8); PG8_WAIT_L(0); PG8_BAR; PG8_MMA(0, 0, At, B0); PG8_MMA(0, 1, At, B1); PG8_BAR; PG8_SCHED;
            PG8_LDA(At, 0, 1); PG8_STAGE(PG8_SB(0, 0), b2, voffB); PG8_STAGE(PG8_SB(0, 1), b2 + hstepB, voffB); PG8_STAGE(PG8_SA(0, 0), a2, w0);
            PG8_WAIT_V(8); PG8_WAIT_L(0); PG8_BAR; PG8_MMA(1, 0, At, B0); PG8_MMA(1, 1, At, B1); PG8_BAR; PG8_SCHED;
            PG8_LDB(B0, 1, 0); PG8_LDB(B1, 1, 1); PG8_SCHED; PG8_LDA(At, 1, 0); PG8_STAGE(PG8_SA(0, 1), a2 + hstepA, w1);
            PG8_WAIT_V(8); PG8_WAIT_L(0); PG8_BAR; PG8_MMA(0, 0, At, B0); PG8_MMA(0, 1, At, B1); PG8_BAR; PG8_SCHED;
            PG8_LDA(At, 1, 1); PG8_STAGE(PG8_SB(1, 0), b3, voffB); PG8_STAGE(PG8_SB(1, 1), b3 + hstepB, voffB); PG8_STAGE(PG8_SA(1, 0), a3, w0);
            PG8_WAIT_V(8); PG8_WAIT_L(0); PG8_BAR; PG8_MMA(1, 0, At, B0); PG8_MMA(1, 1, At, B1); PG8_BAR; PG8_SCHED;
        }
        if (wr == 0) PG8_BAR;
        E(acc, cur, wr, wc, fr, fq);
        if (!has_next) break;
#pragma unroll
        for (int a = 0; a < 2; ++a)
#pragma unroll
            for (int b = 0; b < 2; ++b)
#pragma unroll
                for (int m = 0; m < 4; ++m)
#pragma unroll
                    for (int n = 0; n < 2; ++n) acc[a][b][m][n] = (f32x4){0.f, 0.f, 0.f, 0.f};
        cur = nxt; cA = nA; cB = nB; ++ui;
#pragma unroll
        for (int i = 0; i < 2; ++i) { cv0[i] = nv0[i]; cv1[i] = nv1[i]; }
        if (wr == 1) PG8_BAR;
    }
    PG8_WAIT_V(0);
    PG8_BAR;
#undef PG8_SA
#undef PG8_SB
#undef PG8_STAGE
#undef PG8_LDA
#undef PG8_LDB
#undef PG8_MMA
#undef PG8_WAIT_V
#undef PG8_WAIT_L
#undef PG8_BAR
#undef PG8_SCHED
}
}

struct Args { const void* in[27]; float* out; unsigned char* ws; int ph_lo, ph_hi; };
enum { I_X = 0, I_MEM, I_POS, I_LN1, I_LN2, I_WOUT, I_MKV, I_MQN, I_MKN, I_RGW, I_RGB, I_REW, I_REB, I_WG, I_WU, I_WD, I_RWIN, I_RGN, I_KVLN, I_KVWD, I_KVLG, I_KVWU, I_KN, I_MWIN, I_QLG, I_WUQ, I_QN };
constexpr int NPHASE = 19;

__device__ __forceinline__ void tr_item(const float* W, int ldw, int k0, int n0, const float* gain, bf16_t* WT, int ldt, int dst_row, LAS float* scr, int lane) {
#pragma unroll 8
    for (int i = 0; i < 32; ++i) { const int kk = 2 * i + (lane >> 5); float v = W[(size_t)(k0 + kk) * ldw + n0 + (lane & 31)]; if (gain) v *= gain[k0 + kk]; scr[kk * 33 + (lane & 31)] = v; }
    LDS_WAIT(); asm volatile("" ::: "memory");
    const int c = lane & 7;
#pragma unroll
    for (int j = 0; j < 4; ++j) { const int n = (lane >> 3) + 8 * j; const LAS float* s = scr + (8 * c) * 33 + n;
        u32x4 o; o.x = pk2(s[0 * 33], s[1 * 33]); o.y = pk2(s[2 * 33], s[3 * 33]); o.z = pk2(s[4 * 33], s[5 * 33]); o.w = pk2(s[6 * 33], s[7 * 33]);
        *(u32x4*)(WT + (size_t)(dst_row + n) * ldt + k0 + 8 * c) = o; }
    LDS_WAIT(); asm volatile("" ::: "memory");
}

__device__ __forceinline__ float log_gamma_h(int h) { return log1pf(-exp2f(-5.0f - (float)h)); }

__global__ void __launch_bounds__(512, 2) fwd_kernel(Args args) {
    extern __shared__ __attribute__((aligned(16))) unsigned char lds_raw[];
    LAS unsigned char* lds = (LAS unsigned char*)lds_raw;
    const int tid = threadIdx.x, lane = tid & 63, wave = __builtin_amdgcn_readfirstlane(tid >> 6);
    const int G = gridDim.x, blk = blockIdx.x;
    unsigned char* ws = args.ws;
    unsigned* ctl = (unsigned*)(ws + WS_CTL);
    const int lo = args.ph_lo, hi = args.ph_hi;
    const bool fused = (hi - lo) > 1;
    if (tid < 4) ((volatile LAS unsigned*)(lds + L_BARW))[tid] = 0u;
    __syncthreads();
    XcdBarrier bar; bar.bar = ctl + CW_BAR; bar.x = 0; bar.st = nullptr;
    if (fused) bar = xcd_barrier_post(ctl + CW_BAR, (volatile LAS unsigned*)(lds + L_BARW));
#ifdef ONLY_PHASE
#define IN(k) ((k) == ONLY_PHASE && lo <= (k) && (k) < hi)
#else
#define IN(k) (lo <= (k) && (k) < hi)
#endif
#define SEAM(k) do { if (IN((k) + 1)) xcd_barrier(bar); } while (0)

    const float* x_in = (const float*)args.in[I_X];
    float* out = args.out;
    bf16_t* XA = (bf16_t*)(ws + WS_XA);
    float* rsbase = (float*)(ws + WS_RS0);
    const int* pos = (const int*)args.in[I_POS];
    const f32x2* cs64 = (const f32x2*)(ws + WS_CS64);
    const f32x2* cs32 = (const f32x2*)(ws + WS_CS32);
    const int gw = blk * 8 + wave, NGW = G * 8;
    const int gtid = blk * 512 + tid, NGT = G * 512;

    if (IN(0)) {
        LAS float* scr = (LAS float*)(lds + wave * 16384);
        constexpr int I_A = 16 * 104, I_B = 2 * 16 * 32, I_C = 2 * 16 * 16, I_GU = 128 * 16 * 8, I_DN = 64 * 4 * 32, I_E = 16 * 9, I_F = 16 * 20, I_G = 4 * 48, I_H = 6 * 36;
        constexpr int NITEMS = I_A + I_B + I_C + I_GU + I_DN + I_E + I_F + I_G + I_H;
        for (int it = gw; it < NITEMS; it += NGW) {
            int r = it;
            if (r < I_A) { const int kb = r / 104, nb = r % 104; tr_item((const float*)args.in[I_RWIN], A_IN, 64 * kb, 32 * nb, (const float*)args.in[I_LN1], (bf16_t*)(ws + WS_WIN0), D, 32 * nb, scr, lane); continue; } r -= I_A;
            if (r < I_B) { const int l = r / 512, q = r % 512, kb = q / 32, nb = q % 32; tr_item((const float*)args.in[I_WOUT] + (size_t)l * D * D, D, 64 * kb, 32 * nb, nullptr, (bf16_t*)(ws + WS_WOUT) + (size_t)l * D * D, D, 32 * nb, scr, lane); continue; } r -= I_B;
            if (r < I_C) { const int l = r / 256, q = r % 256, kb = q / 16, nb = q % 16; tr_item((const float*)args.in[I_MKV] + (size_t)l * D * 512, 512, 64 * kb, 32 * nb, nullptr, (bf16_t*)(ws + WS_WMKV), D, l * 512 + 32 * nb, scr, lane); continue; } r -= I_C;
            if (r < I_GU) { const int mtx = r / 128, q = r % 128, kb = q / 8, nb = q % 8; const int le = mtx >> 1, which = mtx & 1, l = le / NE, e = le % NE;
                const float* src = (const float*)args.in[which ? I_WU : I_WG] + (size_t)le * D * DE;
                bf16_t* dst = (bf16_t*)(ws + WS_WEXP + (size_t)l * WEXP_L) + (size_t)e * 512 * D; const int n0 = 32 * nb;
                tr_item(src, DE, 64 * kb, n0, (const float*)args.in[I_LN2] + l * D, dst, D, (n0 / 128) * 256 + which * 128 + (n0 % 128), scr, lane); continue; } r -= I_GU;
            if (r < I_DN) { const int le = r / 128, q = r % 128, kb = q / 32, nb = q % 32, l = le / NE, e = le % NE;
                tr_item((const float*)args.in[I_WD] + (size_t)le * DE * D, D, 64 * kb, 32 * nb, nullptr, (bf16_t*)(ws + WS_WEXP + (size_t)l * WEXP_L + WEXP_DN) + (size_t)e * D * DE, DE, 32 * nb, scr, lane); continue; } r -= I_DN;
            if (r < I_E) { const int kb = r / 9, nb = r % 9; const int n0 = 32 * nb; tr_item((const float*)args.in[I_KVWD], KVL + ROPED, 64 * kb, n0, (const float*)args.in[I_KVLN], (bf16_t*)(ws + WS_WIN1), D, n0 < 256 ? n0 : 896 + (n0 - 256), scr, lane); continue; } r -= I_E;
            if (r < I_F) { const int kb = r / 20, nb = r % 20; const int n0 = 32 * nb; tr_item((const float*)args.in[I_MWIN], QL + MEMW, 64 * kb, n0, (const float*)args.in[I_LN1] + D, (bf16_t*)(ws + WS_WIN1), D, 256 + n0, scr, lane); continue; } r -= I_F;
            if (r < I_G) { const int kb = r / 48, nb = r % 48; tr_item((const float*)args.in[I_KVWU], 1536, 64 * kb, 32 * nb, (const float*)args.in[I_KVLG], (bf16_t*)(ws + WS_WUKV), 256, 32 * nb, scr, lane); continue; } r -= I_G;
            { const int kb = r / 36, nb = r % 36; tr_item((const float*)args.in[I_WUQ], 1152, 64 * kb, 32 * nb, (const float*)args.in[I_QLG], (bf16_t*)(ws + WS_WUQ), 384, 32 * nb, scr, lane); }
        }
        for (int i = gtid; i < 96 * 1024 / 2; i += NGT) ((unsigned*)(ws + WS_WIN1) + 928 * 1024 / 2)[i] = 0u;
        for (int i = gtid; i < 128 * 384 / 2; i += NGT) ((unsigned*)(ws + WS_WUQ) + 1152 * 384 / 2)[i] = 0u;
        for (int i = gtid; i < 2 * 36 * 1024; i += NGT) { const int l = i / (36 * 1024), q = i % (36 * 1024), n = q / 1024, k = q % 1024;
            const float w = (n < 32 ? ((const float*)args.in[I_REW])[((size_t)l * D + k) * NE + n] : ((const float*)args.in[I_RGW])[((size_t)l * D + k) * 4 + (n - 32)]) * ((const float*)args.in[I_LN2])[l * D + k];
            const unsigned h = f2bf(w); const float rem = w - bf2f((unsigned short)h);
            bf16_t* wr_ = (bf16_t*)(ws + WS_WR) + (size_t)l * 2 * 36 * 1024; wr_[n * 1024 + k] = (bf16_t)h; wr_[36 * 1024 + n * 1024 + k] = (bf16_t)f2bf(rem); }
        for (int i = gtid; i < 2 * 36; i += NGT) { const int l = i / 36, n = i % 36; ((float*)(ws + WS_BR))[l * 64 + n] = n < 32 ? ((const float*)args.in[I_REB])[l * NE + n] : ((const float*)args.in[I_RGB])[l * 4 + n - 32]; }
        for (int i = gtid; i < T * 32; i += NGT) { const int t = i >> 5, f = i & 31; const float inv = powf(10000.f, -(float)f / 32.f); const float ang = (float)pos[t] * inv; float s, c; sincosf(ang, &s, &c); ((f32x2*)(ws + WS_CS64))[i] = (f32x2){c, s}; }
        for (int i = gtid; i < T * 16; i += NGT) { const int t = i >> 4, f = i & 15; const float inv = powf(10000.f, -(float)f / 16.f); const float ang = (float)pos[t] * inv; float s, c; sincosf(ang, &s, &c); ((f32x2*)(ws + WS_CS32))[i] = (f32x2){c, s}; }
        for (int i = gtid; i < NB * NMEM * D / 4; i += NGT) { const f32x4 v = ((const f32x4*)args.in[I_MEM])[i]; ((u32x2*)(ws + WS_MEMB))[i] = (u32x2){pk2(v.x, v.y), pk2(v.z, v.w)}; }
        for (int m = gw; m < T; m += NGW) {
            const f32x4* xr = (const f32x4*)(x_in + (size_t)m * D) + lane; f32x4 v[4]; float s = 0.f;
#pragma unroll
            for (int j = 0; j < 4; ++j) { v[j] = xr[64 * j]; s += (v[j].x * v[j].x + v[j].y * v[j].y) + (v[j].z * v[j].z + v[j].w * v[j].w); }
            s = wave_sum(s);
            u32x2* o8 = (u32x2*)(XA + (size_t)m * D) + lane;
#pragma unroll
            for (int j = 0; j < 4; ++j) o8[64 * j] = (u32x2){pk2(v[j].x, v[j].y), pk2(v[j].z, v[j].w)};
            if (lane == 0) rsbase[m] = 1.0f / sqrtf(s * (1.f / D) + EPS);
        }
        SEAM(0);
    }

    if (IN(1)) {
        { pg8::Gemm g{XA, (const bf16_t*)(ws + WS_WIN0), D, D, D}; pg8::StaticOrder S; S.init(T, A_IN, G, blk);
          pg8::EpiBf16S E{(bf16_t*)(ws + WS_PROJ0), A_IN, rsbase, 0};
          pg8::gemm_phase<pg8::EpiBf16S, pg8::StaticOrder, false>(lds, g, S, E, nullptr); }
        { pg8::Gemm g{(const bf16_t*)(ws + WS_MEMB), (const bf16_t*)(ws + WS_WMKV), D, D, D}; pg8::StaticOrder S; S.init(NB * NMEM, D, G, blk);
          pg8::EpiBf16S E{(bf16_t*)(ws + WS_KVM), D, nullptr, 0};
          pg8::gemm_phase<pg8::EpiBf16S, pg8::StaticOrder, false>(lds, g, S, E, nullptr); }
        SEAM(1);
    }

    if (IN(2)) {
        const bf16_t* proj = (const bf16_t*)(ws + WS_PROJ0);
        LAS bf16_t* KT = (LAS bf16_t*)lds; LAS bf16_t* VT = (LAS bf16_t*)(lds + 64 * 136 * 2);
        float* Ut = (float*)(ws + WS_UT);
        const int j = tid >> 2, c = tid & 3;
        for (int u = blk; u < NB * NCH * NH; u += G) {
            const int h = u % NH, bn = u / NH, n = bn % NCH, b = bn / NCH;
            const int t = b * SEQ + n * RCH + j;
            const float lg = log_gamma_h(h);
            const bf16_t* pr = proj + (size_t)t * A_IN;
            const u32x4 ka = *(const u32x4*)(pr + MAINW + h * 64 + 8 * c), kb = *(const u32x4*)(pr + MAINW + h * 64 + 32 + 8 * c);
            const u32x4 va = *(const u32x4*)(pr + 2 * MAINW + h * 64 + 8 * c), vb = *(const u32x4*)(pr + 2 * MAINW + h * 64 + 32 + 8 * c);
            const float sc = 0.125f * __expf(lg * (float)(RCH - 1 - j));
#pragma unroll
            for (int e = 0; e < 8; ++e) { const unsigned wa = ka[e >> 1], wb = kb[e >> 1]; const float x1 = (e & 1) ? bfhi(wa) : bflo(wa), x2 = (e & 1) ? bfhi(wb) : bflo(wb);
                const f32x2 cs = cs64[(size_t)t * 32 + 8 * c + e];
                KT[(8 * c + e) * 136 + j] = (bf16_t)f2bf((x1 * cs.x - x2 * cs.y) * sc); KT[(32 + 8 * c + e) * 136 + j] = (bf16_t)f2bf((x2 * cs.x + x1 * cs.y) * sc);
                const unsigned ua = va[e >> 1], ub = vb[e >> 1];
                VT[(8 * c + e) * 136 + j] = (bf16_t)((e & 1) ? (ua >> 16) : (ua & 0xffffu)); VT[(32 + 8 * c + e) * 136 + j] = (bf16_t)((e & 1) ? (ub >> 16) : (ub & 0xffffu)); }
            __syncthreads();
            const int r16 = lane & 15, q4 = lane >> 4, mt = wave >> 1;
            f32x4 acc2[2] = {(f32x4){0.f, 0.f, 0.f, 0.f}, (f32x4){0.f, 0.f, 0.f, 0.f}};
#pragma unroll
            for (int ks = 0; ks < 4; ++ks) { const bf16x8 a = *(const LAS bf16x8*)(VT + (16 * mt + r16) * 136 + 32 * ks + 8 * q4);
#pragma unroll
                for (int q = 0; q < 2; ++q) { const int nt = 2 * (wave & 1) + q; const bf16x8 bb = *(const LAS bf16x8*)(KT + (16 * nt + r16) * 136 + 32 * ks + 8 * q4); acc2[q] = MFMA16(a, bb, acc2[q]); } }
            float* up = Ut + (size_t)u * 4096;
#pragma unroll
            for (int q = 0; q < 2; ++q) { const int nt = 2 * (wave & 1) + q;
#pragma unroll
                for (int r = 0; r < 4; ++r) up[(16 * mt + 4 * q4 + r) * 64 + 16 * nt + r16] = acc2[q][r]; }
            __syncthreads();
        }
        SEAM(2);
    }

    if (IN(3)) {
        const float* Ut = (const float*)(ws + WS_UT); bf16_t* Rt = (bf16_t*)(ws + WS_RT);
        for (int i = gtid; i < NB * NH * 4096; i += NGT) { const int bh = i >> 12, e = i & 4095, b = bh / NH, h = bh % NH;
            const float dC = __expf(log_gamma_h(h) * (float)RCH); float R = 0.f;
            for (int n = 0; n < NCH; ++n) { const size_t u = (size_t)((b * NCH + n) * NH + h); Rt[u * 4096 + e] = (bf16_t)f2bf(R); R = dC * R + Ut[u * 4096 + e]; } }
        SEAM(3);
    }

    auto mem_attn_unit = [&](int u, int l, const bf16_t* qsrc, int ldq, int qcol) {
        const int qblk = u & 7, head = (u >> 3) & 3, b = u >> 5;
        LAS bf16_t* Kn = (LAS bf16_t*)lds; LAS bf16_t* VTm = (LAS bf16_t*)(lds + 256 * 72 * 2);
        const bf16_t* kvm = (const bf16_t*)(ws + WS_KVM);
        const float* kg = (const float*)args.in[I_MKN] + l * 64; const float* qg = (const float*)args.in[I_MQN] + l * 64;
        { const int key = tid >> 1, half = tid & 1; const bf16_t* kr = kvm + (size_t)(b * NMEM + key) * D + l * 512 + head * 64 + 32 * half;
          u32x4 kk[4], vv[4]; float ss = 0.f;
#pragma unroll
          for (int i = 0; i < 4; ++i) { kk[i] = *(const u32x4*)(kr + 8 * i); vv[i] = *(const u32x4*)(kr + 256 + 8 * i); }
#pragma unroll
          for (int i = 0; i < 4; ++i)
#pragma unroll
              for (int e = 0; e < 4; ++e) { const float a = bflo(kk[i][e]), bq = bfhi(kk[i][e]); ss += a * a + bq * bq; }
          ss += __shfl_xor(ss, 1); const float rstd = 1.0f / sqrtf(ss * (1.f / 64.f) + EPS);
#pragma unroll
          for (int i = 0; i < 4; ++i) { u32x4 o;
#pragma unroll
              for (int e = 0; e < 4; ++e) { const int d = 32 * half + 8 * i + 2 * e; o[e] = pk2(bflo(kk[i][e]) * rstd * kg[d], bfhi(kk[i][e]) * rstd * kg[d + 1]); }
              *(LAS u32x4*)(Kn + key * 72 + 32 * half + 8 * i) = o;
#pragma unroll
              for (int e = 0; e < 4; ++e) { const int d = 32 * half + 8 * i + 2 * e; VTm[d * 264 + key] = (bf16_t)(vv[i][e] & 0xffffu); VTm[(d + 1) * 264 + key] = (bf16_t)(vv[i][e] >> 16); } } }
        __syncthreads();
        const int r16 = lane & 15, q4 = lane >> 4;
        bf16_t* A2 = XA;
        for (int sub = 0; sub < 4; ++sub) {
            const int t = b * SEQ + qblk * 512 + sub * 128 + 16 * wave + r16;
            const bf16_t* qr = qsrc + (size_t)t * ldq + qcol + head * 64;
            const u32x4 q0 = *(const u32x4*)(qr + 8 * q4), q1 = *(const u32x4*)(qr + 32 + 8 * q4);
            float ss = 0.f;
#pragma unroll
            for (int e = 0; e < 4; ++e) { float a = bflo(q0[e]), bq = bfhi(q0[e]); ss += a * a + bq * bq; a = bflo(q1[e]); bq = bfhi(q1[e]); ss += a * a + bq * bq; }
            ss += __shfl_xor(ss, 16); ss += __shfl_xor(ss, 32);
            const float qs = (1.0f / sqrtf(ss * (1.f / 64.f) + EPS)) * (0.125f * 1.4426950408889634f);
            u32x4 qa, qb;
#pragma unroll
            for (int e = 0; e < 4; ++e) { const int d0 = 8 * q4 + 2 * e; qa[e] = pk2(bflo(q0[e]) * qs * qg[d0], bfhi(q0[e]) * qs * qg[d0 + 1]); qb[e] = pk2(bflo(q1[e]) * qs * qg[32 + d0], bfhi(q1[e]) * qs * qg[32 + d0 + 1]); }
            const bf16x8 qf0 = __builtin_bit_cast(bf16x8, qa), qf1 = __builtin_bit_cast(bf16x8, qb);
            f32x4 o[4] = {(f32x4){0.f, 0.f, 0.f, 0.f}, (f32x4){0.f, 0.f, 0.f, 0.f}, (f32x4){0.f, 0.f, 0.f, 0.f}, (f32x4){0.f, 0.f, 0.f, 0.f}};
            float mrow = -INFINITY, ls = 0.f;
#pragma unroll 1
            for (int kc = 0; kc < 4; ++kc) {
                f32x4 st[4]; float mx = -INFINITY;
#pragma unroll
                for (int k4 = 0; k4 < 4; ++k4) { const int kt = 4 * kc + k4; f32x4 a = (f32x4){0.f, 0.f, 0.f, 0.f};
                    a = MFMA16(*(const LAS bf16x8*)(Kn + (16 * kt + r16) * 72 + 8 * q4), qf0, a);
                    a = MFMA16(*(const LAS bf16x8*)(Kn + (16 * kt + r16) * 72 + 32 + 8 * q4), qf1, a);
                    st[k4] = a; mx = fmaxf(mx, fmaxf(fmaxf(a[0], a[1]), fmaxf(a[2], a[3]))); }
                mx = fmaxf(mx, __shfl_xor(mx, 16)); mx = fmaxf(mx, __shfl_xor(mx, 32));
                const float mnew = fmaxf(mrow, mx), alpha = exp2f(mrow - mnew); mrow = mnew;
                float ps = 0.f;
#pragma unroll
                for (int k4 = 0; k4 < 4; ++k4)
#pragma unroll
                    for (int r = 0; r < 4; ++r) { st[k4][r] = exp2f(st[k4][r] - mnew); ps += st[k4][r]; }
                ls = ls * alpha + ps;
#pragma unroll
                for (int dt = 0; dt < 4; ++dt) o[dt] = o[dt] * alpha;
#pragma unroll
                for (int k2 = 0; k2 < 2; ++k2) { const int kk2 = 2 * kc + k2; u32x4 pw; pw.x = pk2(st[2 * k2][0], st[2 * k2][1]); pw.y = pk2(st[2 * k2][2], st[2 * k2][3]); pw.z = pk2(st[2 * k2 + 1][0], st[2 * k2 + 1][1]); pw.w = pk2(st[2 * k2 + 1][2], st[2 * k2 + 1][3]);
                    const bf16x8 pf = __builtin_bit_cast(bf16x8, pw);
#pragma unroll
                    for (int dt = 0; dt < 4; ++dt) { const LAS bf16_t* vp = VTm + (16 * dt + r16) * 264 + 32 * kk2 + 4 * q4; const u32x2 v0 = *(const LAS u32x2*)vp, v1 = *(const LAS u32x2*)(vp + 16);
                        const u32x4 vw = (u32x4){v0.x, v0.y, v1.x, v1.y}; o[dt] = MFMA16(__builtin_bit_cast(bf16x8, vw), pf, o[dt]); } }
            }
            ls += __shfl_xor(ls, 16); ls += __shfl_xor(ls, 32);
            const float il = 1.0f / ls;
#pragma unroll
            for (int dt = 0; dt < 4; ++dt) { const u32x2 w = (u32x2){pk2(o[dt][0] * il, o[dt][1] * il), pk2(o[dt][2] * il, o[dt][3] * il)}; *(u32x2*)(A2 + (size_t)t * D + MAINW + head * 64 + 16 * dt + 4 * q4) = w; }
        }
        __syncthreads();
    };

    if (IN(4)) {
        const bf16_t* proj = (const bf16_t*)(ws + WS_PROJ0); const bf16_t* Rt = (const bf16_t*)(ws + WS_RT);
        LAS bf16_t* Qs = (LAS bf16_t*)lds; LAS bf16_t* Ks = (LAS bf16_t*)(lds + 128 * 72 * 2); LAS bf16_t* VT = (LAS bf16_t*)(lds + 2 * 128 * 72 * 2); LAS bf16_t* Rs = (LAS bf16_t*)(lds + 2 * 128 * 72 * 2 + 64 * 136 * 2);
        const float* gn = (const float*)args.in[I_RGN];
        const int j = tid >> 2, c = tid & 3;
        for (int u = blk; u < NB * NCH * NH; u += G) {
            const int h = u % NH, bn = u / NH, n = bn % NCH, b = bn / NCH;
            const int t = b * SEQ + n * RCH + j;
            const float lg = log_gamma_h(h), lg2 = lg * 1.4426950408889634f;
            const bf16_t* pr = proj + (size_t)t * A_IN;
            { const u32x4 qa = *(const u32x4*)(pr + h * 64 + 8 * c), qb = *(const u32x4*)(pr + h * 64 + 32 + 8 * c);
              const u32x4 ka = *(const u32x4*)(pr + MAINW + h * 64 + 8 * c), kb = *(const u32x4*)(pr + MAINW + h * 64 + 32 + 8 * c);
              const u32x4 va = *(const u32x4*)(pr + 2 * MAINW + h * 64 + 8 * c), vb = *(const u32x4*)(pr + 2 * MAINW + h * 64 + 32 + 8 * c);
              float q1[8], q2[8], k1[8], k2[8];
#pragma unroll
              for (int e = 0; e < 8; ++e) { const f32x2 cs = cs64[(size_t)t * 32 + 8 * c + e];
                  const float xq1 = (e & 1) ? bfhi(qa[e >> 1]) : bflo(qa[e >> 1]), xq2 = (e & 1) ? bfhi(qb[e >> 1]) : bflo(qb[e >> 1]);
                  const float xk1 = (e & 1) ? bfhi(ka[e >> 1]) : bflo(ka[e >> 1]), xk2 = (e & 1) ? bfhi(kb[e >> 1]) : bflo(kb[e >> 1]);
                  q1[e] = xq1 * cs.x - xq2 * cs.y; q2[e] = xq2 * cs.x + xq1 * cs.y; k1[e] = (xk1 * cs.x - xk2 * cs.y) * 0.125f; k2[e] = (xk2 * cs.x + xk1 * cs.y) * 0.125f;
                  VT[(8 * c + e) * 136 + j] = (bf16_t)((e & 1) ? (va[e >> 1] >> 16) : (va[e >> 1] & 0xffffu)); VT[(32 + 8 * c + e) * 136 + j] = (bf16_t)((e & 1) ? (vb[e >> 1] >> 16) : (vb[e >> 1] & 0xffffu)); }
              *(LAS u32x4*)(Qs + j * 72 + 8 * c) = (u32x4){pk2(q1[0], q1[1]), pk2(q1[2], q1[3]), pk2(q1[4], q1[5]), pk2(q1[6], q1[7])};
              *(LAS u32x4*)(Qs + j * 72 + 32 + 8 * c) = (u32x4){pk2(q2[0], q2[1]), pk2(q2[2], q2[3]), pk2(q2[4], q2[5]), pk2(q2[6], q2[7])};
              *(LAS u32x4*)(Ks + j * 72 + 8 * c) = (u32x4){pk2(k1[0], k1[1]), pk2(k1[2], k1[3]), pk2(k1[4], k1[5]), pk2(k1[6], k1[7])};
              *(LAS u32x4*)(Ks + j * 72 + 32 + 8 * c) = (u32x4){pk2(k2[0], k2[1]), pk2(k2[2], k2[3]), pk2(k2[4], k2[5]), pk2(k2[6], k2[7])};
              *(LAS u32x4*)(Rs + (tid >> 3) * 72 + 8 * (tid & 7)) = *(const u32x4*)(Rt + (size_t)u * 4096 + (tid >> 3) * 64 + 8 * (tid & 7)); }
            __syncthreads();
            const int r16 = lane & 15, q4 = lane >> 4, w = wave, i_loc = 16 * w + r16;
            const bf16x8 qf0 = *(const LAS bf16x8*)(Qs + i_loc * 72 + 8 * q4), qf1 = *(const LAS bf16x8*)(Qs + i_loc * 72 + 32 + 8 * q4);
            f32x4 o[4] = {(f32x4){0.f, 0.f, 0.f, 0.f}, (f32x4){0.f, 0.f, 0.f, 0.f}, (f32x4){0.f, 0.f, 0.f, 0.f}, (f32x4){0.f, 0.f, 0.f, 0.f}};
            for (int kk2 = 0; kk2 <= (w >> 1); ++kk2) {
                f32x4 s0 = (f32x4){0.f, 0.f, 0.f, 0.f}, s1 = (f32x4){0.f, 0.f, 0.f, 0.f};
                s0 = MFMA16(*(const LAS bf16x8*)(Ks + (32 * kk2 + r16) * 72 + 8 * q4), qf0, s0); s0 = MFMA16(*(const LAS bf16x8*)(Ks + (32 * kk2 + r16) * 72 + 32 + 8 * q4), qf1, s0);
                const bool two = (2 * kk2 + 1) <= w;
                if (two) { s1 = MFMA16(*(const LAS bf16x8*)(Ks + (32 * kk2 + 16 + r16) * 72 + 8 * q4), qf0, s1); s1 = MFMA16(*(const LAS bf16x8*)(Ks + (32 * kk2 + 16 + r16) * 72 + 32 + 8 * q4), qf1, s1); }
                float p0[4], p1[4];
#pragma unroll
                for (int r = 0; r < 4; ++r) { const int d0 = i_loc - (32 * kk2 + 4 * q4 + r), d1 = d0 - 16;
                    p0[r] = d0 >= 0 ? s0[r] * exp2f(lg2 * (float)d0) : 0.f; p1[r] = (two && d1 >= 0) ? s1[r] * exp2f(lg2 * (float)d1) : 0.f; }
                const u32x4 pw = (u32x4){pk2(p0[0], p0[1]), pk2(p0[2], p0[3]), pk2(p1[0], p1[1]), pk2(p1[2], p1[3])}; const bf16x8 pf = __builtin_bit_cast(bf16x8, pw);
#pragma unroll
                for (int dt = 0; dt < 4; ++dt) { const LAS bf16_t* vp = VT + (16 * dt + r16) * 136 + 32 * kk2 + 4 * q4; const u32x2 v0 = *(const LAS u32x2*)vp, v1 = *(const LAS u32x2*)(vp + 16);
                    const u32x4 vw = (u32x4){v0.x, v0.y, v1.x, v1.y}; o[dt] = MFMA16(__builtin_bit_cast(bf16x8, vw), pf, o[dt]); }
            }
            f32x4 xc[4];
#pragma unroll
            for (int dt = 0; dt < 4; ++dt) { f32x4 a = (f32x4){0.f, 0.f, 0.f, 0.f}; a = MFMA16(*(const LAS bf16x8*)(Rs + (16 * dt + r16) * 72 + 8 * q4), qf0, a); a = MFMA16(*(const LAS bf16x8*)(Rs + (16 * dt + r16) * 72 + 32 + 8 * q4), qf1, a); xc[dt] = a; }
            const float gq = exp2f(lg2 * (float)(i_loc + 1));
            float s1 = 0.f;
#pragma unroll
            for (int dt = 0; dt < 4; ++dt)
#pragma unroll
                for (int r = 0; r < 4; ++r) { o[dt][r] += gq * xc[dt][r]; s1 += o[dt][r]; }
            s1 += __shfl_xor(s1, 16); s1 += __shfl_xor(s1, 32);
            const float mean = s1 * (1.f / 64.f); float s2 = 0.f;
#pragma unroll
            for (int dt = 0; dt < 4; ++dt)
#pragma unroll
                for (int r = 0; r < 4; ++r) { o[dt][r] -= mean; s2 += o[dt][r] * o[dt][r]; }
            s2 += __shfl_xor(s2, 16); s2 += __shfl_xor(s2, 32);
            const float rstd = 1.0f / sqrtf(s2 * (1.f / 64.f) + EPS);
            const int tq = b * SEQ + n * RCH + i_loc;
#pragma unroll
            for (int dt = 0; dt < 4; ++dt) { const int dv = 16 * dt + 4 * q4; const u32x2 gg = *(const u32x2*)(proj + (size_t)tq * A_IN + 3 * MAINW + h * 64 + dv); const f32x4 gv = *(const f32x4*)(gn + h * 64 + dv);
                const float y0 = o[dt][0] * rstd * gv[0] * siluf(bflo(gg.x)), y1 = o[dt][1] * rstd * gv[1] * siluf(bfhi(gg.x)), y2 = o[dt][2] * rstd * gv[2] * siluf(bflo(gg.y)), y3 = o[dt][3] * rstd * gv[3] * siluf(bfhi(gg.y));
                *(u32x2*)(XA + (size_t)tq * D + h * 64 + dv) = (u32x2){pk2(y0, y1), pk2(y2, y3)}; }
            __syncthreads();
        }
        for (int u = blk; u < 256; u += G) mem_attn_unit(u, 0, proj, A_IN, 4 * MAINW);
        SEAM(4);
    }

    if (IN(5)) {
        pg8::Gemm g{XA, (const bf16_t*)(ws + WS_WOUT), D, D, D}; pg8::StaticOrder S; S.init(T, D, G, blk);
        pg8::EpiF32Res E{out, x_in, D};
        pg8::gemm_phase<pg8::EpiF32Res, pg8::StaticOrder, false>(lds, g, S, E, nullptr);
        SEAM(5);
    }

    auto route_phase = [&](int l, float* rs) {
        const float* src = out;
        LAS bf16_t* Wh = (LAS bf16_t*)lds; LAS bf16_t* Wl = (LAS bf16_t*)(lds + 36 * 1032 * 2);
        LAS int* lcnt = (LAS int*)(lds + 152000); LAS int* gbase = lcnt + 32; LAS unsigned* rowER = (LAS unsigned*)(lds + 152000 + 256); LAS float* rowW = (LAS float*)(lds + 152000 + 256 + 1024);
        unsigned* cnt = ctl + CW_CNT + 64 * l; int* list = (int*)(ws + WS_LIST);
        unsigned* tker = (unsigned*)(ws + WS_TKER) + (size_t)l * T * 2; float* tkw = (float*)(ws + WS_TKW) + (size_t)l * T * 2;
        const bf16_t* wrg = (const bf16_t*)(ws + WS_WR) + (size_t)l * 2 * 36 * 1024; const float* br = (const float*)(ws + WS_BR) + l * 64;
        for (int chunk = blk; chunk < T / 128; chunk += G) {
            __syncthreads();
            for (int i = tid; i < 2 * 36 * 128; i += 512) { const int hl = i / (36 * 128), q = i % (36 * 128), n = q / 128, c8 = q % 128; *(LAS u32x4*)((hl ? Wl : Wh) + n * 1032 + 8 * c8) = *(const u32x4*)(wrg + (size_t)hl * 36 * 1024 + n * 1024 + 8 * c8); }
            if (tid < 32) lcnt[tid] = 0;
            __syncthreads();
            const int r16 = lane & 15, q4 = lane >> 4; const int rl = 16 * wave + r16, t = chunk * 128 + rl;
            const float* xr = src + (size_t)t * D; bf16_t* xo = XA + (size_t)t * D;
            f32x4 acc[3] = {(f32x4){0.f, 0.f, 0.f, 0.f}, (f32x4){0.f, 0.f, 0.f, 0.f}, (f32x4){0.f, 0.f, 0.f, 0.f}}; float ss = 0.f;
#pragma unroll 4
            for (int ks = 0; ks < 32; ++ks) { const f32x4 a = *(const f32x4*)(xr + 32 * ks + 8 * q4), bq = *(const f32x4*)(xr + 32 * ks + 8 * q4 + 4);
                ss += (a.x * a.x + a.y * a.y) + (a.z * a.z + a.w * a.w) + (bq.x * bq.x + bq.y * bq.y) + (bq.z * bq.z + bq.w * bq.w);
                const float v[8] = {a.x, a.y, a.z, a.w, bq.x, bq.y, bq.z, bq.w}; unsigned hh[8], ll[8];
#pragma unroll
                for (int e = 0; e < 8; ++e) { hh[e] = f2bf(v[e]); ll[e] = f2bf(v[e] - bf2f((unsigned short)hh[e])); }
                const u32x4 hw = (u32x4){hh[0] | (hh[1] << 16), hh[2] | (hh[3] << 16), hh[4] | (hh[5] << 16), hh[6] | (hh[7] << 16)}, lw = (u32x4){ll[0] | (ll[1] << 16), ll[2] | (ll[3] << 16), ll[4] | (ll[5] << 16), ll[6] | (ll[7] << 16)};
                *(u32x4*)(xo + 32 * ks + 8 * q4) = hw;
                const bf16x8 xh = __builtin_bit_cast(bf16x8, hw), xl = __builtin_bit_cast(bf16x8, lw);
#pragma unroll
                for (int nt = 0; nt < 3; ++nt) { const int nrow = (16 * nt + r16) < 36 ? (16 * nt + r16) : 35;
                    const bf16x8 wh = *(const LAS bf16x8*)(Wh + nrow * 1032 + 32 * ks + 8 * q4), wl = *(const LAS bf16x8*)(Wl + nrow * 1032 + 32 * ks + 8 * q4);
                    acc[nt] = MFMA16(wh, xh, acc[nt]); acc[nt] = MFMA16(wh, xl, acc[nt]); acc[nt] = MFMA16(wl, xh, acc[nt]); } }
            ss += __shfl_xor(ss, 16); ss += __shfl_xor(ss, 32);
            const float rstd = 1.0f / sqrtf(ss * (1.f / D) + EPS);
            if (q4 == 0) rs[t] = rstd;
            __syncthreads();
            LAS float* lg = (LAS float*)lds;
#pragma unroll
            for (int nt = 0; nt < 3; ++nt)
#pragma unroll
                for (int r = 0; r < 4; ++r) { const int n = 16 * nt + 4 * q4 + r; if (n < 36) lg[rl * 40 + n] = acc[nt][r] * rstd + br[n]; }
            LDS_WAIT(); asm volatile("" ::: "memory");
            if (q4 == 0) {
                const LAS float* L = lg + rl * 40;
                int grp = 0; float gm = L[32];
#pragma unroll
                for (int gi = 1; gi < 4; ++gi) if (L[32 + gi] > gm) { gm = L[32 + gi]; grp = gi; }
                float gs = 0.f;
#pragma unroll
                for (int gi = 0; gi < 4; ++gi) gs += __expf(L[32 + gi] - gm);
                const float pg = 1.0f / gs;
                int i0 = 0; float m0 = L[8 * grp];
#pragma unroll
                for (int ji = 1; ji < 8; ++ji) { const float v = L[8 * grp + ji]; if (v > m0) { m0 = v; i0 = ji; } }
                int i1 = -1; float m1 = -INFINITY;
#pragma unroll
                for (int ji = 0; ji < 8; ++ji) { const float v = L[8 * grp + ji]; if (ji != i0 && v > m1) { m1 = v; i1 = ji; } }
                const float e1 = __expf(m1 - m0); const float w0 = pg / (1.f + e1), w1 = pg * e1 / (1.f + e1);
                const int ex0 = grp * 8 + i0, ex1 = grp * 8 + i1;
                const int lr0 = atomicAdd((int*)(lcnt + ex0), 1), lr1 = atomicAdd((int*)(lcnt + ex1), 1);
                rowER[rl * 2] = ((unsigned)ex0 << 16) | (unsigned)lr0; rowER[rl * 2 + 1] = ((unsigned)ex1 << 16) | (unsigned)lr1; rowW[rl * 2] = w0; rowW[rl * 2 + 1] = w1;
            }
            __syncthreads();
            if (tid < 32) gbase[tid] = (int)__hip_atomic_fetch_add(cnt + tid, (unsigned)lcnt[tid], RLX_AGENT);
            __syncthreads();
            if (tid < 256) { const int row = tid >> 1, k = tid & 1; const unsigned er = rowER[row * 2 + k]; const int e = er >> 16, rank = gbase[e] + (int)(er & 0xffffu); const int tt = chunk * 128 + row;
                list[(size_t)e * T + rank] = tt; tker[(size_t)tt * 2 + k] = ((unsigned)e << 16) | (unsigned)rank; tkw[(size_t)tt * 2 + k] = rowW[row * 2 + k]; }
        }
    };
    auto build_tb = [&](int l) {
        LAS int* tb = (LAS int*)(lds + L_MISC); LAS int* cntL = (LAS int*)(lds + L_MISC + 256);
        __syncthreads();
        if (tid == 0) { int a = 0; for (int e = 0; e < NE; ++e) { const int c = (int)__hip_atomic_load(ctl + CW_CNT + 64 * l + e, RLX_AGENT); cntL[e] = c; tb[e] = a; a += (c + 255) >> 8; } tb[32] = a; }
        __syncthreads();
    };
    auto moe_gateup = [&](int l, const float* rs) {
        build_tb(l);
        LAS int* tb = (LAS int*)(lds + L_MISC); LAS int* cntL = (LAS int*)(lds + L_MISC + 256); LAS int* tokL = (LAS int*)(lds + L_MISC + 1024); LAS float* rsL = (LAS float*)(lds + L_MISC + 4096);
        const int* list = (const int*)(ws + WS_LIST);
        pg8::MoeOrder S{tb, 2, G, blk};
        { pg8::Unit u; for (int i = 0; i < 3 && S.next(i, u); ++i) { const int e = u.pn >> 1; if (tid < 256) { int rank = (u.pm - tb[e]) * 256 + tid; if (rank >= cntL[e]) rank = 0; const int tk = list[(size_t)e * T + rank]; tokL[i * 256 + tid] = tk; rsL[i * 256 + tid] = rs[tk]; } } }
        __syncthreads();
        pg8::Gemm g{XA, (const bf16_t*)(ws + WS_WEXP + (size_t)l * WEXP_L), D, D, D};
        pg8::EpiSwiGLU E{(bf16_t*)(ws + WS_HID), rsL};
        pg8::gemm_phase<pg8::EpiSwiGLU, pg8::MoeOrder, true>(lds, g, S, E, tokL);
    };
    auto moe_down = [&](int l) {
        build_tb(l);
        LAS int* tb = (LAS int*)(lds + L_MISC);
        pg8::MoeOrder S{tb, 4, G, blk};
        pg8::Gemm g{(const bf16_t*)(ws + WS_HID), (const bf16_t*)(ws + WS_WEXP + (size_t)l * WEXP_L + WEXP_DN), DE, DE, DE};
        pg8::EpiBf16S E{(bf16_t*)(ws + WS_YS), D, nullptr, 4};
        pg8::gemm_phase<pg8::EpiBf16S, pg8::MoeOrder, false>(lds, g, S, E, nullptr);
    };
    auto combine_phase = [&](int l, float* rs) {
        build_tb(l);
        LAS int* tb = (LAS int*)(lds + L_MISC);
        const unsigned* tker = (const unsigned*)(ws + WS_TKER) + (size_t)l * T * 2; const float* tkw = (const float*)(ws + WS_TKW) + (size_t)l * T * 2; const bf16_t* ys = (const bf16_t*)(ws + WS_YS);
        for (int m = gw; m < T; m += NGW) {
            const unsigned er0 = tker[(size_t)m * 2], er1 = tker[(size_t)m * 2 + 1]; const float w0 = tkw[(size_t)m * 2], w1 = tkw[(size_t)m * 2 + 1];
            const size_t s0 = (size_t)tb[er0 >> 16] * 256 + (er0 & 0xffffu), s1 = (size_t)tb[er1 >> 16] * 256 + (er1 & 0xffffu);
            f32x4* xr = (f32x4*)(out + (size_t)m * D) + lane; const u32x2* y0 = (const u32x2*)(ys + s0 * D) + lane; const u32x2* y1 = (const u32x2*)(ys + s1 * D) + lane;
            f32x4 v[4]; float s = 0.f;
#pragma unroll
            for (int j = 0; j < 4; ++j) { v[j] = xr[64 * j]; const u32x2 a = y0[64 * j], bq = y1[64 * j];
                v[j].x += w0 * bflo(a.x) + w1 * bflo(bq.x); v[j].y += w0 * bfhi(a.x) + w1 * bfhi(bq.x); v[j].z += w0 * bflo(a.y) + w1 * bflo(bq.y); v[j].w += w0 * bfhi(a.y) + w1 * bfhi(bq.y);
                s += (v[j].x * v[j].x + v[j].y * v[j].y) + (v[j].z * v[j].z + v[j].w * v[j].w); xr[64 * j] = v[j]; }
            if (rs) { s = wave_sum(s); u32x2* o8 = (u32x2*)(XA + (size_t)m * D) + lane;
#pragma unroll
                for (int j = 0; j < 4; ++j) o8[64 * j] = (u32x2){pk2(v[j].x, v[j].y), pk2(v[j].z, v[j].w)};
                if (lane == 0) rs[m] = 1.0f / sqrtf(s * (1.f / D) + EPS); }
        }
    };

    if (IN(6)) { route_phase(0, rsbase + T); SEAM(6); }
    if (IN(7)) { moe_gateup(0, rsbase + T); SEAM(7); }
    if (IN(8)) { moe_down(0); SEAM(8); }
    if (IN(9)) { combine_phase(0, rsbase + 2 * T); SEAM(9); }

    if (IN(10)) {
        pg8::Gemm g{XA, (const bf16_t*)(ws + WS_WIN1), D, D, D}; pg8::StaticOrder S; S.init(T, D, G, blk);
        pg8::EpiBf16S E{(bf16_t*)(ws + WS_PROJ1), D, rsbase + 2 * T, 0};
        pg8::gemm_phase<pg8::EpiBf16S, pg8::StaticOrder, false>(lds, g, S, E, nullptr);
        SEAM(10);
    }
    if (IN(11)) {
        { pg8::Gemm g{(const bf16_t*)(ws + WS_PROJ1), (const bf16_t*)(ws + WS_WUKV), D, KVL, KVL}; pg8::StaticOrder S; S.init(T, LDKV, G, blk);
          pg8::EpiBf16S E{(bf16_t*)(ws + WS_KV), LDKV, nullptr, 0};
          pg8::gemm_phase<pg8::EpiBf16S, pg8::StaticOrder, false>(lds, g, S, E, nullptr); }
        { pg8::Gemm g{(const bf16_t*)(ws + WS_PROJ1) + KVL, (const bf16_t*)(ws + WS_WUQ), D, QL, QL}; pg8::StaticOrder S; S.init(T, LDQ, G, blk);
          pg8::EpiBf16S E{(bf16_t*)(ws + WS_Q), LDQ, nullptr, 0};
          pg8::gemm_phase<pg8::EpiBf16S, pg8::StaticOrder, false>(lds, g, S, E, nullptr); }
        SEAM(11);
    }
    if (IN(12)) {
        const bf16_t* proj1 = (const bf16_t*)(ws + WS_PROJ1); bf16_t* KV = (bf16_t*)(ws + WS_KV); bf16_t* Qb = (bf16_t*)(ws + WS_Q); bf16_t* Vt = (bf16_t*)(ws + WS_VT);
        const float* kg = (const float*)args.in[I_KN]; const float* qg = (const float*)args.in[I_QN];
        LAS bf16_t* Vtile = (LAS bf16_t*)lds;
        const float QSC = 0.10206207261596575f * 1.4426950408889634f;
        for (int tl = blk; tl < T / 64; tl += G) {
            const int hh = lane >> 2, s = lane & 3; const bool act = lane < 48;
            for (int rr = 0; rr < 8; ++rr) {
                const int tloc = 8 * wave + rr, t = tl * 64 + tloc; const bf16_t* p1 = proj1 + (size_t)t * D;
                const u32x2 cw = *(const u32x2*)(p1 + 4 * lane); float skv = bflo(cw.x) * bflo(cw.x) + bfhi(cw.x) * bfhi(cw.x) + bflo(cw.y) * bflo(cw.y) + bfhi(cw.y) * bfhi(cw.y);
                float sq = 0.f; if (act) { const u32x4 qw = *(const u32x4*)(p1 + KVL + 8 * lane);
#pragma unroll
                    for (int e = 0; e < 4; ++e) sq += bflo(qw[e]) * bflo(qw[e]) + bfhi(qw[e]) * bfhi(qw[e]); }
                skv = wave_sum(skv); sq = wave_sum(sq);
                const float rkv = 1.0f / sqrtf(skv * (1.f / KVL) + EPS), rq = 1.0f / sqrtf(sq * (1.f / QL) + EPS);
                if (act) {
                    bf16_t* kvr = KV + (size_t)t * LDKV + hh * 128;
                    const u32x4 kn0 = *(const u32x4*)(kvr + 16 * s), kn1 = *(const u32x4*)(kvr + 16 * s + 8), vv0 = *(const u32x4*)(kvr + 64 + 16 * s), vv1 = *(const u32x4*)(kvr + 64 + 16 * s + 8);
                    const u32x2 ra = *(const u32x2*)(p1 + 896 + 4 * s), rb = *(const u32x2*)(p1 + 912 + 4 * s);
                    float kn[16], ar[4], br2[4]; float ssk = 0.f;
#pragma unroll
                    for (int e = 0; e < 4; ++e) { kn[2 * e] = bflo(kn0[e]) * rkv; kn[2 * e + 1] = bfhi(kn0[e]) * rkv; kn[8 + 2 * e] = bflo(kn1[e]) * rkv; kn[8 + 2 * e + 1] = bfhi(kn1[e]) * rkv; }
                    ar[0] = bflo(ra.x); ar[1] = bfhi(ra.x); ar[2] = bflo(ra.y); ar[3] = bfhi(ra.y); br2[0] = bflo(rb.x); br2[1] = bfhi(rb.x); br2[2] = bflo(rb.y); br2[3] = bfhi(rb.y);
#pragma unroll
                    for (int e = 0; e < 16; ++e) ssk += kn[e] * kn[e];
#pragma unroll
                    for (int e = 0; e < 4; ++e) ssk += ar[e] * ar[e] + br2[e] * br2[e];
                    ssk += __shfl_xor(ssk, 1); ssk += __shfl_xor(ssk, 2);
                    const float rk = 1.0f / sqrtf(ssk * (1.f / QKH) + EPS);
                    u32x4 o0, o1;
#pragma unroll
                    for (int e = 0; e < 4; ++e) { o0[e] = pk2(kn[2 * e] * rk * kg[16 * s + 2 * e], kn[2 * e + 1] * rk * kg[16 * s + 2 * e + 1]); o1[e] = pk2(kn[8 + 2 * e] * rk * kg[16 * s + 8 + 2 * e], kn[8 + 2 * e + 1] * rk * kg[16 * s + 8 + 2 * e + 1]); }
                    float r1[4], r2[4];
#pragma unroll
                    for (int e = 0; e < 4; ++e) { const int i = 4 * s + e; const f32x2 cs = cs32[(size_t)t * 16 + i]; const float a = ar[e] * rk * kg[64 + i], bq = br2[e] * rk * kg[80 + i]; r1[e] = a * cs.x - bq * cs.y; r2[e] = bq * cs.x + a * cs.y; }
#pragma unroll
                    for (int e = 0; e < 4; ++e) { Vtile[(hh * 64 + 16 * s + 2 * e) * 72 + tloc] = (bf16_t)f2bf(bflo(vv0[e]) * rkv); Vtile[(hh * 64 + 16 * s + 2 * e + 1) * 72 + tloc] = (bf16_t)f2bf(bfhi(vv0[e]) * rkv);
                        Vtile[(hh * 64 + 16 * s + 8 + 2 * e) * 72 + tloc] = (bf16_t)f2bf(bflo(vv1[e]) * rkv); Vtile[(hh * 64 + 16 * s + 8 + 2 * e + 1) * 72 + tloc] = (bf16_t)f2bf(bfhi(vv1[e]) * rkv); }
                    *(u32x4*)(kvr + 16 * s) = o0; *(u32x4*)(kvr + 16 * s + 8) = o1;
                    *(u32x2*)(kvr + 64 + 4 * s) = (u32x2){pk2(r1[0], r1[1]), pk2(r1[2], r1[3])}; *(u32x2*)(kvr + 80 + 4 * s) = (u32x2){pk2(r2[0], r2[1]), pk2(r2[2], r2[3])};
                    bf16_t* qr = Qb + (size_t)t * LDQ + hh * QKH;
                    const u32x4 qn0 = *(const u32x4*)(qr + 16 * s), qn1 = *(const u32x4*)(qr + 16 * s + 8); const u32x2 qa = *(const u32x2*)(qr + 64 + 4 * s), qb = *(const u32x2*)(qr + 80 + 4 * s);
                    float qn[16], qa4[4], qb4[4]; float ssq = 0.f;
#pragma unroll
                    for (int e = 0; e < 4; ++e) { qn[2 * e] = bflo(qn0[e]) * rq; qn[2 * e + 1] = bfhi(qn0[e]) * rq; qn[8 + 2 * e] = bflo(qn1[e]) * rq; qn[8 + 2 * e + 1] = bfhi(qn1[e]) * rq; }
                    qa4[0] = bflo(qa.x) * rq; qa4[1] = bfhi(qa.x) * rq; qa4[2] = bflo(qa.y) * rq; qa4[3] = bfhi(qa.y) * rq; qb4[0] = bflo(qb.x) * rq; qb4[1] = bfhi(qb.x) * rq; qb4[2] = bflo(qb.y) * rq; qb4[3] = bfhi(qb.y) * rq;
#pragma unroll
                    for (int e = 0; e < 16; ++e) ssq += qn[e] * qn[e];
#pragma unroll
                    for (int e = 0; e < 4; ++e) ssq += qa4[e] * qa4[e] + qb4[e] * qb4[e];
                    ssq += __shfl_xor(ssq, 1); ssq += __shfl_xor(ssq, 2);
                    const float rqh = (1.0f / sqrtf(ssq * (1.f / QKH) + EPS)) * QSC;
                    u32x4 p0, p1v;
#pragma unroll
                    for (int e = 0; e < 4; ++e) { p0[e] = pk2(qn[2 * e] * rqh * qg[16 * s + 2 * e], qn[2 * e + 1] * rqh * qg[16 * s + 2 * e + 1]); p1v[e] = pk2(qn[8 + 2 * e] * rqh * qg[16 * s + 8 + 2 * e], qn[8 + 2 * e + 1] * rqh * qg[16 * s + 8 + 2 * e + 1]); }
                    float t1[4], t2[4];
#pragma unroll
                    for (int e = 0; e < 4; ++e) { const int i = 4 * s + e; const f32x2 cs = cs32[(size_t)t * 16 + i]; const float a = qa4[e] * rqh * qg[64 + i], bq = qb4[e] * rqh * qg[80 + i]; t1[e] = a * cs.x - bq * cs.y; t2[e] = bq * cs.x + a * cs.y; }
                    *(u32x4*)(qr + 16 * s) = p0; *(u32x4*)(qr + 16 * s + 8) = p1v;
                    *(u32x2*)(qr + 64 + 4 * s) = (u32x2){pk2(t1[0], t1[1]), pk2(t1[2], t1[3])}; *(u32x2*)(qr + 80 + 4 * s) = (u32x2){pk2(t2[0], t2[1]), pk2(t2[2], t2[3])};
                }
            }
            __syncthreads();
            { const int b = (tl * 64) / SEQ, s0 = (tl * 64) % SEQ;
              for (int i = tid; i < 768 * 8; i += 512) { const int row = i >> 3, ch = i & 7; *(u32x4*)(Vt + ((size_t)(b * NH * 64 + row)) * SEQ + s0 + 8 * ch) = *(const LAS u32x4*)(Vtile + row * 72 + 8 * ch); } }
            __syncthreads();
        }
        SEAM(12);
    }

    if (IN(13)) {
        const bf16_t* Qb = (const bf16_t*)(ws + WS_Q); const bf16_t* KV = (const bf16_t*)(ws + WS_KV); const bf16_t* Vt = (const bf16_t*)(ws + WS_VT);
        constexpr int KSTR = 104, VSTR = 68, KBUF = 64 * KSTR * 2, VBUF = 64 * VSTR * 2;
        const int r32 = lane & 31, hi5 = lane >> 5;
        for (int pi = 0; pi < 3; ++pi) {
            const int p = blk + G * pi; if (p >= 768) break;
            const int bh = p >> 3, sidx = p & 7, b = bh / NH, h = bh % NH;
            for (int which = 0; which < 2; ++which) {
                const int qb = which ? sidx : 15 - sidx;
                const int NT = 4 * (qb + 1);
                const int trow = b * SEQ + qb * 256 + 32 * wave + r32;
                bf16x8 qf[6];
#pragma unroll
                for (int d0 = 0; d0 < 6; ++d0) qf[d0] = *(const bf16x8*)(Qb + (size_t)trow * LDQ + h * QKH + 16 * d0 + 8 * hi5);
                const int kc0 = tid, kc1 = 512 + tid; const bool k1v = kc1 < 768;
                const int kkey0 = kc0 / 12, kch0 = kc0 % 12, kkey1 = k1v ? kc1 / 12 : 0, kch1 = k1v ? kc1 % 12 : 0;
                const int vdv = tid >> 3, vch = tid & 7;
                const bf16_t* kbase = KV + (size_t)(b * SEQ) * LDKV + h * 128; const bf16_t* vbase = Vt + (size_t)(bh * 64 + vdv) * SEQ + 8 * vch;
                u32x4 kr0, kr1, vr;
                kr0 = *(const u32x4*)(kbase + (size_t)kkey0 * LDKV + 8 * kch0); kr1 = *(const u32x4*)(kbase + (size_t)kkey1 * LDKV + 8 * kch1); vr = *(const u32x4*)vbase;
                __syncthreads();
                { LAS unsigned char* kb_ = lds; LAS unsigned char* vb_ = lds + 2 * KBUF;
                  *(LAS u32x4*)(kb_ + (kkey0 * KSTR + 8 * kch0) * 2) = kr0; if (k1v) *(LAS u32x4*)(kb_ + (kkey1 * KSTR + 8 * kch1) * 2) = kr1;
                  *(LAS u32x2*)(vb_ + (vdv * VSTR + 8 * vch) * 2) = (u32x2){vr.x, vr.y}; *(LAS u32x2*)(vb_ + (vdv * VSTR + 8 * vch + 4) * 2) = (u32x2){vr.z, vr.w}; }
                __syncthreads();
                f32x16 o0, o1;
#pragma unroll
                for (int r = 0; r < 16; ++r) { o0[r] = 0.f; o1[r] = 0.f; }
                float mrow = -INFINITY, lrow = 0.f;
                for (int kt = 0; kt < NT; ++kt) {
                    const int cur = kt & 1;
                    if (kt + 1 < NT) { const size_t ko = (size_t)(64 * (kt + 1)) * LDKV; kr0 = *(const u32x4*)(kbase + ko + (size_t)kkey0 * LDKV + 8 * kch0); kr1 = *(const u32x4*)(kbase + ko + (size_t)kkey1 * LDKV + 8 * kch1); vr = *(const u32x4*)(vbase + 64 * (kt + 1)); }
                    const LAS bf16_t* Kc = (const LAS bf16_t*)(lds + cur * KBUF); const LAS bf16_t* Vc = (const LAS bf16_t*)(lds + 2 * KBUF + cur * VBUF);
                    f32x16 s0, s1;
#pragma unroll
                    for (int r = 0; r < 16; ++r) { s0[r] = 0.f; s1[r] = 0.f; }
#pragma unroll
                    for (int d0 = 0; d0 < 6; ++d0) { s0 = MFMA32(*(const LAS bf16x8*)(Kc + r32 * KSTR + 16 * d0 + 8 * hi5), qf[d0], s0); s1 = MFMA32(*(const LAS bf16x8*)(Kc + (32 + r32) * KSTR + 16 * d0 + 8 * hi5), qf[d0], s1); }
                    if (kt >= NT - 4) { const int qrel = qb * 256 + 32 * wave + r32 - 64 * kt;
#pragma unroll
                        for (int r = 0; r < 16; ++r) { const int kv = (r & 3) + 8 * (r >> 2) + 4 * hi5; if (kv > qrel) s0[r] = -INFINITY; if (kv + 32 > qrel) s1[r] = -INFINITY; } }
                    float mx = -INFINITY;
#pragma unroll
                    for (int r = 0; r < 16; ++r) mx = fmaxf(mx, fmaxf(s0[r], s1[r]));
                    mx = fmaxf(mx, __shfl_xor(mx, 32));
                    const float mnew = fmaxf(mrow, mx); const float alpha = exp2f(mrow - mnew); mrow = mnew;
                    float ps = 0.f;
#pragma unroll
                    for (int r = 0; r < 16; ++r) { s0[r] = exp2f(s0[r] - mnew); s1[r] = exp2f(s1[r] - mnew); ps += s0[r] + s1[r]; }
                    lrow = lrow * alpha + ps;
#pragma unroll
                    for (int r = 0; r < 16; ++r) { o0[r] *= alpha; o1[r] *= alpha; }
#pragma unroll
                    for (int st = 0; st < 4; ++st) {
                        u32x4 pw;
                        if (st < 2) pw = (u32x4){pk2(s0[8 * st], s0[8 * st + 1]), pk2(s0[8 * st + 2], s0[8 * st + 3]), pk2(s0[8 * st + 4], s0[8 * st + 5]), pk2(s0[8 * st + 6], s0[8 * st + 7])};
                        else pw = (u32x4){pk2(s1[8 * (st - 2)], s1[8 * (st - 2) + 1]), pk2(s1[8 * (st - 2) + 2], s1[8 * (st - 2) + 3]), pk2(s1[8 * (st - 2) + 4], s1[8 * (st - 2) + 5]), pk2(s1[8 * (st - 2) + 6], s1[8 * (st - 2) + 7])};
                        const bf16x8 pf = __builtin_bit_cast(bf16x8, pw);
                        { const LAS bf16_t* vp = Vc + r32 * VSTR + 16 * st + 4 * hi5; const u32x2 v0 = *(const LAS u32x2*)vp, v1 = *(const LAS u32x2*)(vp + 8); const u32x4 vw = (u32x4){v0.x, v0.y, v1.x, v1.y}; o0 = MFMA32(__builtin_bit_cast(bf16x8, vw), pf, o0); }
                        { const LAS bf16_t* vp = Vc + (32 + r32) * VSTR + 16 * st + 4 * hi5; const u32x2 v0 = *(const LAS u32x2*)vp, v1 = *(const LAS u32x2*)(vp + 8); const u32x4 vw = (u32x4){v0.x, v0.y, v1.x, v1.y}; o1 = MFMA32(__builtin_bit_cast(bf16x8, vw), pf, o1); }
                    }
                    if (kt + 1 < NT) { LAS unsigned char* kb_ = lds + (cur ^ 1) * KBUF; LAS unsigned char* vb_ = lds + 2 * KBUF + (cur ^ 1) * VBUF;
                        *(LAS u32x4*)(kb_ + (kkey0 * KSTR + 8 * kch0) * 2) = kr0; if (k1v) *(LAS u32x4*)(kb_ + (kkey1 * KSTR + 8 * kch1) * 2) = kr1;
                        *(LAS u32x2*)(vb_ + (vdv * VSTR + 8 * vch) * 2) = (u32x2){vr.x, vr.y}; *(LAS u32x2*)(vb_ + (vdv * VSTR + 8 * vch + 4) * 2) = (u32x2){vr.z, vr.w}; }
                    __syncthreads();
                }
                lrow += __shfl_xor(lrow, 32);
                const float il = 1.0f / lrow;
                bf16_t* orow = XA + (size_t)trow * D + h * 64;
#pragma unroll
                for (int g4 = 0; g4 < 4; ++g4) { *(u32x2*)(orow + 8 * g4 + 4 * hi5) = (u32x2){pk2(o0[4 * g4] * il, o0[4 * g4 + 1] * il), pk2(o0[4 * g4 + 2] * il, o0[4 * g4 + 3] * il)};
                    *(u32x2*)(orow + 32 + 8 * g4 + 4 * hi5) = (u32x2){pk2(o1[4 * g4] * il, o1[4 * g4 + 1] * il), pk2(o1[4 * g4 + 2] * il, o1[4 * g4 + 3] * il)}; }
            }
        }
        __syncthreads();
        for (int u = blk; u < 256; u += G) mem_attn_unit(u, 1, (const bf16_t*)(ws + WS_PROJ1), D, KVL + QL);
        SEAM(13);
    }
    if (IN(14)) {
        pg8::Gemm g{XA, (const bf16_t*)(ws + WS_WOUT) + (size_t)D * D, D, D, D}; pg8::StaticOrder S; S.init(T, D, G, blk);
        pg8::EpiF32Res E{out, out, D};
        pg8::gemm_phase<pg8::EpiF32Res, pg8::StaticOrder, false>(lds, g, S, E, nullptr);
        SEAM(14);
    }
    if (IN(15)) { route_phase(1, rsbase + 3 * T); SEAM(15); }
    if (IN(16)) { moe_gateup(1, rsbase + 3 * T); SEAM(16); }
    if (IN(17)) { moe_down(1); SEAM(17); }
    if (IN(18)) { combine_phase(1, nullptr); }
#undef IN
#undef SEAM
}

#ifndef MK_FUSED
#define MK_FUSED 0
#endif
#ifndef MK_LAST_PHASE
#define MK_LAST_PHASE NPHASE
#endif
extern "C" void kernel_launch(void* const* d_in, const int* in_sizes, int n_in, void* d_out, int out_size, void* d_ws, size_t ws_size, hipStream_t stream) {
    static int grid = 0;
    if (grid == 0) {
        if (n_in != 27 || out_size != T * D || ws_size < WS_END) { fprintf(stderr, "kernel_launch: unexpected shapes (n_in %d out %d ws %zu)\n", n_in, out_size, ws_size); grid = -1; return; }
        int dev = 0, cus = 0, per_cu = 0;
        if (hipGetDevice(&dev) != hipSuccess || hipDeviceGetAttribute(&cus, hipDeviceAttributeMultiprocessorCount, dev) != hipSuccess) { grid = -1; return; }
        if (hipFuncSetAttribute((const void*)fwd_kernel, hipFuncAttributeMaxDynamicSharedMemorySize, LDS_BYTES) != hipSuccess) { fprintf(stderr, "kernel_launch: hipFuncSetAttribute failed\n"); grid = -1; return; }
        if (hipOccupancyMaxActiveBlocksPerMultiprocessor(&per_cu, (const void*)fwd_kernel, 512, LDS_BYTES) != hipSuccess || per_cu < 1) { fprintf(stderr, "kernel_launch: occupancy query says %d\n", per_cu); (void)hipGetLastError(); per_cu = 1; }
        grid = cus;
    }
    if (grid < 0) return;
    (void)hipMemsetAsync((char*)d_ws + WS_CTL, 0, CTL_ZERO_BYTES, stream);
    Args a{};
    for (int i = 0; i < 27; ++i) a.in[i] = d_in[i];
    a.out = (float*)d_out; a.ws = (unsigned char*)d_ws;
#if MK_FUSED
    a.ph_lo = 0; a.ph_hi = MK_LAST_PHASE;
    hipLaunchKernelGGL(fwd_kernel, dim3(grid), dim3(512), LDS_BYTES, stream, a);
#else
    for (int ph = 0; ph < MK_LAST_PHASE; ++ph) { a.ph_lo = ph; a.ph_hi = ph + 1; hipLaunchKernelGGL(fwd_kernel, dim3(grid), dim3(512), LDS_BYTES, stream, a); }
#endif
}
```

```cpp
#include <hip/hip_runtime.h>
#include <cstdio>
#include <cstdint>

#define GAS __attribute__((address_space(1)))
#define LAS __attribute__((address_space(3)))
typedef unsigned short bf16_t;
typedef short bf16x8 __attribute__((ext_vector_type(8)));
typedef short s16x4 __attribute__((ext_vector_type(4)));
typedef float f32x4 __attribute__((ext_vector_type(4)));
typedef float f32x16 __attribute__((ext_vector_type(16)));
typedef float f32x2 __attribute__((ext_vector_type(2)));
typedef unsigned u32x4 __attribute__((ext_vector_type(4)));
typedef unsigned u32x2 __attribute__((ext_vector_type(2)));

constexpr int D = 1024, NB = 8, SEQ = 4096, T = NB * SEQ;
constexpr int NH = 12, HD = 64, MAINW = 768, MEMW = 256, NMEM = 256;
constexpr int A_IN = 4 * MAINW + MEMW;
constexpr int QL = 384, KVL = 256, QKH = 96, ROPED = 32;
constexpr int NE = 32, DE = 256;
constexpr int RCH = 128, NCH = SEQ / RCH;
constexpr float EPS = 1e-6f;
constexpr int PMAX = 2 * T + NE * 256;
constexpr int LDQ = 1280, LDKV = 1536;

constexpr size_t MiB = 1u << 20;
constexpr size_t WS_CTL = 0, CTL_ZERO_BYTES = 1 * MiB;
constexpr size_t WS_WIN0 = 1 * MiB;
constexpr size_t WS_WOUT = WS_WIN0 + (size_t)A_IN * D * 2;
constexpr size_t WS_WMKV = WS_WOUT + (size_t)2 * D * D * 2;
constexpr size_t WS_WIN1 = WS_WMKV + (size_t)D * D * 2;
constexpr size_t WS_WUKV = WS_WIN1 + (size_t)D * D * 2;
constexpr size_t WS_WUQ = WS_WUKV + (size_t)1536 * 256 * 2;
constexpr size_t WS_WR = WS_WUQ + (size_t)1280 * 384 * 2;
constexpr size_t WS_BR = WS_WR + (size_t)2 * 2 * 36 * 1024 * 2;
constexpr size_t WS_RS0 = WS_BR + 4096;
constexpr size_t WS_TKER = WS_RS0 + (size_t)4 * T * 4;
constexpr size_t WS_TKW = WS_TKER + (size_t)2 * T * 2 * 4;
constexpr size_t WS_SMALL_END = WS_TKW + (size_t)2 * T * 2 * 4;
static_assert(WS_SMALL_END <= 20 * MiB, "small region");
constexpr size_t WS_CS64 = 20 * MiB;
constexpr size_t WS_CS32 = 28 * MiB;
constexpr size_t WS_WEXP = 32 * MiB;
constexpr size_t WEXP_L = 48 * MiB, WEXP_DN = 32 * MiB;
constexpr size_t WS_MEMB = 128 * MiB;
constexpr size_t WS_KVM = 132 * MiB;
constexpr size_t WS_LIST = 136 * MiB;
constexpr size_t WS_XA = 144 * MiB;
constexpr size_t WS_BIG = 208 * MiB;
constexpr size_t WS_PROJ0 = WS_BIG;
constexpr size_t WS_UT = WS_BIG + 208 * MiB;
constexpr size_t WS_RT = WS_UT + 48 * MiB;
constexpr size_t WS_HID = WS_BIG;
constexpr size_t WS_YS = WS_BIG + 36 * MiB;
constexpr size_t WS_PROJ1 = WS_BIG;
constexpr size_t WS_KV = WS_BIG + 64 * MiB;
constexpr size_t WS_Q = WS_KV + 96 * MiB;
constexpr size_t WS_VT = WS_Q + 80 * MiB;
constexpr size_t WS_END = 512 * MiB;
static_assert(WS_RT + 24 * MiB <= WS_END && WS_VT + 48 * MiB <= WS_END && WS_YS + (size_t)PMAX * 1024 * 2 <= WS_END && (size_t)PMAX * 256 * 2 <= 36 * MiB, "ws map");
constexpr int CW_CNT = 64;
constexpr int CW_BAR = 4096;

constexpr int LDS_BYTES = 163840;
constexpr int L_MISC = 131072;
constexpr int L_BARW = LDS_BYTES - 16;

#define RLX_AGENT __ATOMIC_RELAXED, __HIP_MEMORY_SCOPE_AGENT
#define LDS_WAIT() asm volatile("s_waitcnt lgkmcnt(0)" ::: "memory")
#define VM_WAIT() asm volatile("s_waitcnt vmcnt(0)" ::: "memory")
__device__ __forceinline__ unsigned f2bf(float f) { unsigned u = __builtin_bit_cast(unsigned, f); return (u + 0x7fffu + ((u >> 16) & 1u)) >> 16; }
__device__ __forceinline__ unsigned pk2(float lo, float hi) { return f2bf(lo) | (f2bf(hi) << 16); }
__device__ __forceinline__ float bf2f(unsigned short b) { return __builtin_bit_cast(float, (unsigned)b << 16); }
__device__ __forceinline__ float bflo(unsigned w) { return __builtin_bit_cast(float, w << 16); }
__device__ __forceinline__ float bfhi(unsigned w) { return __builtin_bit_cast(float, w & 0xffff0000u); }
__device__ __forceinline__ float wave_sum(float v) {
#pragma unroll
    for (int o = 1; o < 64; o <<= 1) v += __shfl_xor(v, o);
    return v;
}
__device__ __forceinline__ float siluf(float a) { return a / (1.f + __expf(-a)); }
#define MFMA16(a, b, c) __builtin_amdgcn_mfma_f32_16x16x32_bf16((a), (b), (c), 0, 0, 0)
#define MFMA32(a, b, c) __builtin_amdgcn_mfma_f32_32x32x16_bf16((a), (b), (c), 0, 0, 0)

#define XB_TMO      128
#define XB_XCNT(j)  (256  + 64 * (j))
#define XB_XSUB(j)  (1280 + 64 * (j))
#define XB_XGEN(j)  (2304 + 64 * (j))
#define XB_TOP      3328
#define XB_TOPGEN   3392
#define XCD_BAR_WORDS 3456
#define XB_SPIN_CAP (1u << 18)
__device__ __forceinline__ unsigned xb_ld(unsigned* p)              { return __hip_atomic_load(p, __ATOMIC_RELAXED, __HIP_MEMORY_SCOPE_AGENT); }
__device__ __forceinline__ unsigned xb_add(unsigned* p, unsigned v) { return __hip_atomic_fetch_add(p, v, __ATOMIC_RELAXED, __HIP_MEMORY_SCOPE_AGENT); }
__device__ __forceinline__ unsigned xb_xcc_id() { return (unsigned)__builtin_amdgcn_s_getreg((3 << 11) | 20) & 0xFu; }
#define XB_SPIN(cond, bar) do { unsigned _sp = 0; while (cond) { __builtin_amdgcn_s_sleep(1); \
    if ((++_sp & 255u) == 0u) { if (xb_ld(&(bar)[XB_TMO])) break; if (_sp > XB_SPIN_CAP) { atomicAdd(&(bar)[XB_TMO], 1u); break; } } } } while (0)
struct XcdBarrier { unsigned* bar; unsigned x; volatile LAS unsigned* st; };
__device__ __forceinline__ XcdBarrier xcd_barrier_post(unsigned* bar, volatile LAS unsigned* st) {
    XcdBarrier b; b.bar = bar; b.x = xb_xcc_id(); b.st = st;
    if (threadIdx.x == 0) (void)xb_add(&bar[XB_XCNT(b.x)], 1u);
    return b;
}
__device__ __forceinline__ void xcd_barrier_complete(unsigned* bar, unsigned x, unsigned& nloc, unsigned& nx) {
    const unsigned G = gridDim.x * gridDim.y * gridDim.z;
    unsigned sum, cnt, mine, sp = 0u;
    for (;;) {
        sum = 0u; cnt = 0u; mine = 0u;
#pragma unroll
        for (unsigned j = 0; j < 16; ++j) { const unsigned c = xb_ld(&bar[XB_XCNT(j)]); sum += c; cnt += (c > 0u) ? 1u : 0u; mine = (j == x) ? c : mine; }
        if (sum == G) break;
        __builtin_amdgcn_s_sleep(1);
        if ((++sp & 255u) == 0u) { if (xb_ld(&bar[XB_TMO])) break; if (sp > XB_SPIN_CAP) { atomicAdd(&bar[XB_TMO], 1u); break; } }
    }
    nloc = mine > 0u ? mine : 1u; nx = cnt > 0u ? cnt : 1u;
}
__device__ __forceinline__ void xcd_barrier(const XcdBarrier& b) {
    asm volatile("s_waitcnt vmcnt(0)" ::: "memory");
    __syncthreads();
    if (threadIdx.x == 0) {
        unsigned* bar = b.bar;
        __builtin_amdgcn_s_waitcnt(0);
        unsigned nloc = b.st[0], nx = b.st[1];
        if (nloc == 0u) { xcd_barrier_complete(bar, b.x, nloc, nx); b.st[0] = nloc; b.st[1] = nx; }
        const unsigned old = xb_add(&bar[XB_XSUB(b.x)], 1u);
        const unsigned gen = old / nloc;
        if (old + 1u == (gen + 1u) * nloc) {
            __builtin_amdgcn_fence(__ATOMIC_RELEASE, "agent");
            asm volatile("s_waitcnt vmcnt(0)" ::: "memory");
            const unsigned og = xb_add(&bar[XB_TOP], 1u);
            const unsigned tg = og / nx;
            if (og + 1u == (tg + 1u) * nx) xb_add(&bar[XB_TOPGEN], 1u);
            else XB_SPIN(xb_ld(&bar[XB_TOPGEN]) == tg, bar);
            __builtin_amdgcn_fence(__ATOMIC_ACQUIRE, "agent");
            xb_add(&bar[XB_XGEN(b.x)], 1u);
            asm volatile("s_waitcnt vmcnt(0)" ::: "memory");
        } else {
            XB_SPIN(xb_ld(&bar[XB_XGEN(b.x)]) == gen, bar);
            __builtin_amdgcn_fence(__ATOMIC_ACQUIRE, "agent");
            asm volatile("s_waitcnt vmcnt(0)" ::: "memory");
        }
    }
    __syncthreads();
}

namespace pg8 {
constexpr int BM = 256, BK = 64, HALF = 128, HTB = HALF * BK * 2, STAGE_BYTES = 8 * HTB, NXCD = 8, WGM = 8;
__host__ __device__ __forceinline__ int lds_byte(int r, int c) { const int st = (r >> 4) * 2 + (c >> 5), rr = r & 15, cc = c & 31, ob = rr * 64 + cc * 2; return st * 1024 + (ob ^ (((ob >> 9) & 1) << 5)); }
__host__ __device__ __forceinline__ void stage_rc(int b, int& R, int& C) { const int st = b / 1024, sb = b % 1024, swz = sb ^ (((sb >> 9) & 1) << 5); R = (st >> 1) * 16 + swz / 64; C = (st & 1) * 32 + (swz % 64) / 2; }
__host__ __device__ __forceinline__ int perm32(int rho) { const int n = rho >> 4, i = rho & 15; return 8 * (i >> 2) + 4 * n + (i & 3); }
struct Unit { int pm, pn, ord; };
struct Gemm { const bf16_t* A; const bf16_t* Bt; int lda, ldb, K; };
struct StaticOrder {
    int nM, nN, nwg, G, c;
    __device__ void init(int M, int N, int G_, int c_) { nM = M / BM; nN = N / BM; nwg = nM * nN; G = G_; c = c_; }
    __device__ bool next(int i, Unit& u) const {
        const long L = (long)i * G + c; if (L >= nwg) return false;
        int wgid = (int)L; { const int q = nwg / NXCD, r = nwg % NXCD, xcd = wgid % NXCD, off = wgid / NXCD; wgid = (xcd < r ? xcd * (q + 1) : r * (q + 1) + (xcd - r) * q) + off; }
        const int nig = WGM * nN, gid = wgid / nig, fm = gid * WGM, gsz = (nM - fm) < WGM ? (nM - fm) : WGM;
        u.pm = fm + ((wgid % nig) % gsz); u.pn = (wgid % nig) / gsz; u.ord = i; return true;
    }
};
struct MoeOrder {
    const LAS int* tb; int nNe, G, c;
    __device__ bool next(int i, Unit& u) const {
        const int L = i * G + c; const int NT = tb[32]; if (L >= NT * nNe) return false;
        const int rtg = L / nNe, pn = L % nNe; int e = 0; while (tb[e + 1] <= rtg) ++e;
        u.pm = rtg; u.pn = e * nNe + pn; u.ord = i; return true;
    }
};
__device__ __forceinline__ unsigned cvt_pk_bf16(float lo, float hi) { typedef __bf16 b2 __attribute__((ext_vector_type(2))); f32x2 v = {lo, hi}; b2 b = __builtin_convertvector(v, b2); return __builtin_bit_cast(unsigned, b); }

struct EpiBf16S {
    static constexpr bool PERM = true;
    bf16_t* O; int ldc; const float* rs; int pnmod;
    __device__ __forceinline__ void operator()(const f32x4 (&acc)[2][2][4][2], const Unit& u, int wr, int wc, int fr, int fq) const {
        const int row0 = u.pm * BM + wr * 64 + fr; const int pn = pnmod ? (u.pn % pnmod) : u.pn; const int col0 = pn * BM + wc * 32 + 8 * fq;
#pragma unroll
        for (int ai = 0; ai < 2; ++ai)
#pragma unroll
            for (int m = 0; m < 4; ++m) { const int row = row0 + ai * HALF + m * 16; const float s = rs ? rs[row] : 1.f; bf16_t* rowp = O + (size_t)row * ldc + col0;
#pragma unroll
                for (int bj = 0; bj < 2; ++bj) { const f32x4 v0 = acc[ai][bj][m][0] * s, v1 = acc[ai][bj][m][1] * s;
                    u32x4 w; w.x = cvt_pk_bf16(v0[0], v0[1]); w.y = cvt_pk_bf16(v0[2], v0[3]); w.z = cvt_pk_bf16(v1[0], v1[1]); w.w = cvt_pk_bf16(v1[2], v1[3]);
                    *(u32x4*)(rowp + bj * HALF) = w; } }
    }
};
struct EpiSwiGLU {
    static constexpr bool PERM = true;
    bf16_t* O; const LAS float* rsL;
    __device__ __forceinline__ void operator()(const f32x4 (&acc)[2][2][4][2], const Unit& u, int wr, int wc, int fr, int fq) const {
        const int col0 = (u.pn & 1) * HALF + wc * 32 + 8 * fq;
#pragma unroll
        for (int ai = 0; ai < 2; ++ai)
#pragma unroll
            for (int m = 0; m < 4; ++m) { const int lr = ai * HALF + wr * 64 + m * 16 + fr; const float s = rsL[u.ord * 256 + lr]; bf16_t* rowp = O + (size_t)(u.pm * BM + lr) * 256 + col0;
                float h[8];
#pragma unroll
                for (int n = 0; n < 2; ++n)
#pragma unroll
                    for (int j = 0; j < 4; ++j) { const float g = acc[ai][0][m][n][j] * s, up = acc[ai][1][m][n][j] * s; h[n * 4 + j] = siluf(g) * up; }
                u32x4 w; w.x = cvt_pk_bf16(h[0], h[1]); w.y = cvt_pk_bf16(h[2], h[3]); w.z = cvt_pk_bf16(h[4], h[5]); w.w = cvt_pk_bf16(h[6], h[7]);
                *(u32x4*)rowp = w; }
    }
};
struct EpiF32Res {
    static constexpr bool PERM = false;
    float* C; const float* R; int ldc;
    __device__ __forceinline__ void operator()(const f32x4 (&acc)[2][2][4][2], const Unit& u, int wr, int wc, int fr, int fq) const {
        const int row0 = u.pm * BM + wr * 64 + fr, col0 = u.pn * BM + wc * 32 + 4 * fq;
#pragma unroll
        for (int ai = 0; ai < 2; ++ai)
#pragma unroll
            for (int m = 0; m < 4; ++m) { const size_t off = (size_t)(row0 + ai * HALF + m * 16) * ldc + col0;
#pragma unroll
                for (int bj = 0; bj < 2; ++bj)
#pragma unroll
                    for (int n = 0; n < 2; ++n) { const f32x4 r = *(const f32x4*)(R + off + bj * HALF + n * 16); *(f32x4*)(C + off + bj * HALF + n * 16) = acc[ai][bj][m][n] + r; } }
    }
};

template <class Epi, class Sched, bool GATHER>
__device__ __forceinline__ void gemm_phase(LAS unsigned char* lds, const Gemm g, const Sched& S, const Epi& E, const LAS int* tokL) {
    const int tid = threadIdx.x, wid = __builtin_amdgcn_readfirstlane(tid >> 6), lane = tid & 63, wr = wid >> 2, wc = wid & 3, fr = lane & 15, fq = lane >> 4;
    const int K = g.K, nt = K / BK;
    unsigned voffA[2], voffB[2]; int RA[2], CA[2];
#pragma unroll
    for (int i = 0; i < 2; ++i) { int R, C; stage_rc(tid * 16 + i * 8192, R, C); const int Rb = Epi::PERM ? ((R & ~31) + perm32(R & 31)) : R; RA[i] = R; CA[i] = C;
        voffA[i] = (unsigned)(R * g.lda + C) * 2u; voffB[i] = (unsigned)(Rb * g.ldb + C) * 2u; }
    const size_t kstep = (size_t)(BK * 2);
    const size_t hstepA = GATHER ? 0 : (size_t)HALF * g.lda * 2, hstepB = (size_t)HALF * g.ldb * 2;
    const size_t tstepA = 2 * (size_t)HALF * g.lda * 2, tstepB = 2 * hstepB;
    const unsigned ldsw = (unsigned)wid * 1024u;
    const int aoff = lds_byte(wr * 64 + fr, fq * 8), boff = lds_byte(wc * 32 + fr, fq * 8);
#define PG8_SA(b, h) (((b) * 2 + (h)) * HTB)
#define PG8_SB(b, h) ((4 + (b) * 2 + (h)) * HTB)
#define PG8_STAGE(bufoff, gbase, voff) do { _Pragma("unroll") for (int _i = 0; _i < 2; ++_i) \
        __builtin_amdgcn_global_load_lds((const unsigned*)((const char*)(gbase) + (voff)[_i]), (LAS unsigned*)(lds + (bufoff) + ldsw + _i * 8192), 16, 0, 0); } while (0)
#define PG8_LDA(dst, b, h) do { _Pragma("unroll") for (int m = 0; m < 4; ++m) _Pragma("unroll") for (int k = 0; k < 2; ++k) dst[m][k] = *(const LAS bf16x8*)(lds + PG8_SA(b, h) + aoff + m * 2048 + k * 1024); } while (0)
#define PG8_LDB(dst, b, h) do { _Pragma("unroll") for (int n = 0; n < 2; ++n) _Pragma("unroll") for (int k = 0; k < 2; ++k) dst[n][k] = *(const LAS bf16x8*)(lds + PG8_SB(b, h) + boff + n * 2048 + k * 1024); } while (0)
#define PG8_MMA(ai, bj, At, Bt) do { __builtin_amdgcn_s_setprio(1); _Pragma("unroll") for (int m = 0; m < 4; ++m) _Pragma("unroll") for (int n = 0; n < 2; ++n) _Pragma("unroll") for (int k = 0; k < 2; ++k) \
        acc[ai][bj][m][n] = __builtin_amdgcn_mfma_f32_16x16x32_bf16(Bt[n][k], At[m][k], acc[ai][bj][m][n], 0, 0, 0); __builtin_amdgcn_s_setprio(0); } while (0)
#define PG8_WAIT_V(n) asm volatile("s_waitcnt vmcnt(" #n ")" ::: "memory")
#define PG8_WAIT_L(n) asm volatile("s_waitcnt lgkmcnt(" #n ")" ::: "memory")
#define PG8_BAR __builtin_amdgcn_s_barrier()
#define PG8_SCHED __builtin_amdgcn_sched_barrier(0)
    Unit cur, nxt; int ui = 0;
    if (!S.next(0, cur)) return;
    f32x4 acc[2][2][4][2];
#pragma unroll
    for (int a = 0; a < 2; ++a)
#pragma unroll
        for (int b = 0; b < 2; ++b)
#pragma unroll
            for (int m = 0; m < 4; ++m)
#pragma unroll
                for (int n = 0; n < 2; ++n) acc[a][b][m][n] = (f32x4){0.f, 0.f, 0.f, 0.f};
    bf16x8 At[4][2], B0[2][2], B1[2][2];
    unsigned cv0[2], cv1[2], nv0[2], nv1[2];
    if constexpr (GATHER) {
#pragma unroll
        for (int i = 0; i < 2; ++i) { cv0[i] = (unsigned)(tokL[cur.ord * 256 + RA[i]] * g.lda + CA[i]) * 2u; cv1[i] = (unsigned)(tokL[cur.ord * 256 + HALF + RA[i]] * g.lda + CA[i]) * 2u; nv0[i] = cv0[i]; nv1[i] = cv1[i]; }
    } else {
#pragma unroll
        for (int i = 0; i < 2; ++i) { cv0[i] = voffA[i]; cv1[i] = voffA[i]; nv0[i] = voffA[i]; nv1[i] = voffA[i]; }
    }
    const char* cA = (const char*)g.A + (GATHER ? (size_t)0 : (size_t)cur.pm * tstepA); const char* cB = (const char*)g.Bt + (size_t)cur.pn * tstepB;
    PG8_STAGE(PG8_SB(0, 0), cB, voffB); PG8_STAGE(PG8_SB(0, 1), cB + hstepB, voffB); PG8_STAGE(PG8_SA(0, 0), cA, cv0); PG8_STAGE(PG8_SA(0, 1), cA + hstepA, cv1);
    if (wr == 1) PG8_BAR;
    PG8_WAIT_V(2); PG8_BAR;
    PG8_STAGE(PG8_SB(1, 0), cB + kstep, voffB); PG8_STAGE(PG8_SA(1, 0), cA + kstep, cv0); PG8_STAGE(PG8_SB(1, 1), cB + hstepB + kstep, voffB);
    PG8_WAIT_V(6); PG8_BAR;
    for (;;) {
        const bool has_next = S.next(ui + 1, nxt);
        const char* nA = has_next ? (const char*)g.A + (GATHER ? (size_t)0 : (size_t)nxt.pm * tstepA) : cA; const char* nB = has_next ? (const char*)g.Bt + (size_t)nxt.pn * tstepB : cB;
        if constexpr (GATHER) { if (has_next) {
#pragma unroll
            for (int i = 0; i < 2; ++i) { nv0[i] = (unsigned)(tokL[nxt.ord * 256 + RA[i]] * g.lda + CA[i]) * 2u; nv1[i] = (unsigned)(tokL[nxt.ord * 256 + HALF + RA[i]] * g.lda + CA[i]) * 2u; } } }
#pragma unroll 1
        for (int t = 0; t < nt; t += 2) {
            const bool last = (t == nt - 2);
            const char* a1 = cA + (size_t)(t + 1) * kstep;
            const char* a2 = last ? nA : cA + (size_t)(t + 2) * kstep; const char* b2 = last ? nB : cB + (size_t)(t + 2) * kstep;
            const char* a3 = a2 + kstep; const char* b3 = b2 + kstep;
            unsigned w0[2], w1[2];
#pragma unroll
            for (int i = 0; i < 2; ++i) { w0[i] = last ? nv0[i] : cv0[i]; w1[i] = last ? nv1[i] : cv1[i]; }
            PG8_LDB(B0, 0, 0); PG8_LDB(B1, 0, 1); PG8_SCHED; PG8_LDA(At, 0, 0); PG8_STAGE(PG8_SA(1, 1), a1 + hstepA, cv1);
            PG8_WAIT_V(8); PG8_WAIT_L(0); PG8_BAR; PG8_MMA(0, 0, At, B0); PG8_MMA(0, 1, At, B1); PG8_BAR; PG8_SCHED;
            PG8_LDA(At, 0, 1); PG8_STAGE(PG8_SB(0, 0), b2, voffB); PG8_STAGE(PG8_SB(0, 1), b2 + hstepB, voffB); PG8_STAGE(PG8_SA(0, 0), a2, w0);
            PG8_WAIT_V(8); PG8_WAIT_L(0); PG8_BAR; PG8_MMA(1, 0, At, B0); PG8_MMA(1, 1, At, B1); PG8_BAR; PG8_SCHED;
            PG8_LDB(B0, 1, 0); PG8_LDB(B1, 1, 1); PG8_SCHED; PG8_LDA(At, 1, 0); PG8_STAGE(PG8_SA(0, 1), a2 + hstepA, w1);
            PG8_WAIT_V(8); PG8_WAIT_L(0); PG8_BAR; PG8_MMA(0, 0, At, B0); PG8_MMA(0, 1, At, B1); PG8_BAR; PG8_SCHED;
            PG8_LDA(At, 1, 1); PG8_STAGE(PG8_SB(1, 0), b3, voffB); PG8_STAGE(PG8_SB(1, 1), b3 + hstepB, voffB); PG8_STAGE(PG8_SA(1, 0), a3, w0);
            PG8_WAIT_V(8); PG8_WAIT_L(0); PG8_BAR; PG8_MMA(1, 0, At, B0); PG8_MMA(1, 1, At, B1); PG8_BAR; PG8_SCHED;
        }
        if (wr == 0) PG8_BAR;
        E(acc, cur, wr, wc, fr, fq);
        if (!has_next) break;
#pragma unroll
        for (int a = 0; a < 2; ++a)
#pragma unroll
            for (int b = 0; b < 2; ++b)
#pragma unroll
                for (int m = 0; m < 4; ++m)
#pragma unroll
                    for (int n = 0; n < 2; ++n) acc[a][b][m][n] = (f32x4){0.f, 0.f, 0.f, 0.f};
        cur = nxt; cA = nA; cB = nB; ++ui;
#pragma unroll
        for (int i = 0; i < 2; ++i) { cv0[i] = nv0[i]; cv1[i] = nv1[i]; }
        if (wr == 1) PG8_BAR;
    }
    PG8_WAIT_V(0);
    PG8_BAR;
#undef PG8_SA
#undef PG8_SB
#undef PG8_STAGE
#undef PG8_LDA
#undef PG8_LDB
#undef PG8_MMA
#undef PG8_WAIT_V
#undef PG8_WAIT_L
#undef PG8_BAR
#undef PG8_SCHED
}
}

struct Args { const void* in[27]; float* out; unsigned char* ws; int ph_lo, ph_hi; };
enum { I_X = 0, I_MEM, I_POS, I_LN1, I_LN2, I_WOUT, I_MKV, I_MQN, I_MKN, I_RGW, I_RGB, I_REW, I_REB, I_WG, I_WU, I_WD, I_RWIN, I_RGN, I_KVLN, I_KVWD, I_KVLG, I_KVWU, I_KN, I_MWIN, I_QLG, I_WUQ, I_QN };
constexpr int NPHASE = 19;

__device__ __forceinline__ void tr_item(const float* W, int ldw, int k0, int n0, const float* gain, bf16_t* WT, int ldt, int dst_row, LAS float* scr, int lane) {
#pragma unroll 8
    for (int i = 0; i < 32; ++i) { const int kk = 2 * i + (lane >> 5); float v = W[(size_t)(k0 + kk) * ldw + n0 + (lane & 31)]; if (gain) v *= gain[k0 + kk]; scr[kk * 33 + (lane & 31)] = v; }
    LDS_WAIT(); asm volatile("" ::: "memory");
    const int c = lane & 7;
#pragma unroll
    for (int j = 0; j < 4; ++j) { const int n = (lane >> 3) + 8 * j; const LAS float* s = scr + (8 * c) * 33 + n;
        u32x4 o; o.x = pk2(s[0 * 33], s[1 * 33]); o.y = pk2(s[2 * 33], s[3 * 33]); o.z = pk2(s[4 * 33], s[5 * 33]); o.w = pk2(s[6 * 33], s[7 * 33]);
        *(u32x4*)(WT + (size_t)(dst_row + n) * ldt + k0 + 8 * c) = o; }
    LDS_WAIT(); asm volatile("" ::: "memory");
}

__device__ __forceinline__ float log_gamma_h(int h) { return log1pf(-exp2f(-5.0f - (float)h)); }

__global__ void __launch_bounds__(512, 2) fwd_kernel(Args args) {
    extern __shared__ __attribute__((aligned(16))) unsigned char lds_raw[];
    LAS unsigned char* lds = (LAS unsigned char*)lds_raw;
    const int tid = threadIdx.x, lane = tid & 63, wave = __builtin_amdgcn_readfirstlane(tid >> 6);
    const int G = gridDim.x, blk = blockIdx.x;
    unsigned char* ws = args.ws;
    unsigned* ctl = (unsigned*)(ws + WS_CTL);
    const int lo = args.ph_lo, hi = args.ph_hi;
    const bool fused = (hi - lo) > 1;
    if (tid < 4) ((volatile LAS unsigned*)(lds + L_BARW))[tid] = 0u;
    __syncthreads();
    XcdBarrier bar; bar.bar = ctl + CW_BAR; bar.x = 0; bar.st = nullptr;
    if (fused) bar = xcd_barrier_post(ctl + CW_BAR, (volatile LAS unsigned*)(lds + L_BARW));
#ifdef ONLY_PHASE
#define IN(k) ((k) == ONLY_PHASE && lo <= (k) && (k) < hi)
#else
#define IN(k) (lo <= (k) && (k) < hi)
#endif
#define SEAM(k) do { if (IN((k) + 1)) xcd_barrier(bar); } while (0)

    const float* x_in = (const float*)args.in[I_X];
    float* out = args.out;
    bf16_t* XA = (bf16_t*)(ws + WS_XA);
    float* rsbase = (float*)(ws + WS_RS0);
    const int* pos = (const int*)args.in[I_POS];
    const f32x2* cs64 = (const f32x2*)(ws + WS_CS64);
    const f32x2* cs32 = (const f32x2*)(ws + WS_CS32);
    const int gw = blk * 8 + wave, NGW = G * 8;
    const int gtid = blk * 512 + tid, NGT = G * 512;

    if (IN(0)) {
        LAS float* scr = (LAS float*)(lds + wave * 16384);
        constexpr int I_A = 16 * 104, I_B = 2 * 16 * 32, I_C = 2 * 16 * 16, I_GU = 128 * 16 * 8, I_DN = 64 * 4 * 32, I_E = 16 * 9, I_F = 16 * 20, I_G = 4 * 48, I_H = 6 * 36;
        constexpr int NITEMS = I_A + I_B + I_C + I_GU + I_DN + I_E + I_F + I_G + I_H;
        for (int it = gw; it < NITEMS; it += NGW) {
            int r = it;
            if (r < I_A) { const int kb = r / 104, nb = r % 104; tr_item((const float*)args.in[I_RWIN], A_IN, 64 * kb, 32 * nb, (const float*)args.in[I_LN1], (bf16_t*)(ws + WS_WIN0), D, 32 * nb, scr, lane); continue; } r -= I_A;
            if (r < I_B) { const int l = r / 512, q = r % 512, kb = q / 32, nb = q % 32; tr_item((const float*)args.in[I_WOUT] + (size_t)l * D * D, D, 64 * kb, 32 * nb, nullptr, (bf16_t*)(ws + WS_WOUT) + (size_t)l * D * D, D, 32 * nb, scr, lane); continue; } r -= I_B;
            if (r < I_C) { const int l = r / 256, q = r % 256, kb = q / 16, nb = q % 16; tr_item((const float*)args.in[I_MKV] + (size_t)l * D * 512, 512, 64 * kb, 32 * nb, nullptr, (bf16_t*)(ws + WS_WMKV), D, l * 512 + 32 * nb, scr, lane); continue; } r -= I_C;
            if (r < I_GU) { const int mtx = r / 128, q = r % 128, kb = q / 8, nb = q % 8; const int le = mtx >> 1, which = mtx & 1, l = le / NE, e = le % NE;
                const float* src = (const float*)args.in[which ? I_WU : I_WG] + (size_t)le * D * DE;
                bf16_t* dst = (bf16_t*)(ws + WS_WEXP + (size_t)l * WEXP_L) + (size_t)e * 512 * D; const int n0 = 32 * nb;
                tr_item(src, DE, 64 * kb, n0, (const float*)args.in[I_LN2] + l * D, dst, D, (n0 / 128) * 256 + which * 128 + (n0 % 128), scr, lane); continue; } r -= I_GU;
            if (r < I_DN) { const int le = r / 128, q = r % 128, kb = q / 32, nb = q % 32, l = le / NE, e = le % NE;
                tr_item((const float*)args.in[I_WD] + (size_t)le * DE * D, D, 64 * kb, 32 * nb, nullptr, (bf16_t*)(ws + WS_WEXP + (size_t)l * WEXP_L + WEXP_DN) + (size_t)e * D * DE, DE, 32 * nb, scr, lane); continue; } r -= I_DN;
            if (r < I_E) { const int kb = r / 9, nb = r % 9; const int n0 = 32 * nb; tr_item((const float*)args.in[I_KVWD], KVL + ROPED, 64 * kb, n0, (const float*)args.in[I_KVLN], (bf16_t*)(ws + WS_WIN1), D, n0 < 256 ? n0 : 896 + (n0 - 256), scr, lane); continue; } r -= I_E;
            if (r < I_F) { const int kb = r / 20, nb = r % 20; const int n0 = 32 * nb; tr_item((const float*)args.in[I_MWIN], QL + MEMW, 64 * kb, n0, (const float*)args.in[I_LN1] + D, (bf16_t*)(ws + WS_WIN1), D, 256 + n0, scr, lane); continue; } r -= I_F;
            if (r < I_G) { const int kb = r / 48, nb = r % 48; tr_item((const float*)args.in[I_KVWU], 1536, 64 * kb, 32 * nb, (const float*)args.in[I_KVLG], (bf16_t*)(ws + WS_WUKV), 256, 32 * nb, scr, lane); continue; } r -= I_G;
            { const int kb = r / 36, nb = r % 36; tr_item((const float*)args.in[I_WUQ], 1152, 64 * kb, 32 * nb, (const float*)args.in[I_QLG], (bf16_t*)(ws + WS_WUQ), 384, 32 * nb, scr, lane); }
        }
        for (int i = gtid; i < 96 * 1024 / 2; i += NGT) ((unsigned*)(ws + WS_WIN1) + 928 * 1024 / 2)[i] = 0u;
        for (int i = gtid; i < 128 * 384 / 2; i += NGT) ((unsigned*)(ws + WS_WUQ) + 1152 * 384 / 2)[i] = 0u;
        for (int i = gtid; i < 2 * 36 * 1024; i += NGT) { const int l = i / (36 * 1024), q = i % (36 * 1024), n = q / 1024, k = q % 1024;
            const float w = (n < 32 ? ((const float*)args.in[I_REW])[((size_t)l * D + k) * NE + n] : ((const float*)args.in[I_RGW])[((size_t)l * D + k) * 4 + (n - 32)]) * ((const float*)args.in[I_LN2])[l * D + k];
            const unsigned h = f2bf(w); const float rem = w - bf2f((unsigned short)h);
            bf16_t* wr_ = (bf16_t*)(ws + WS_WR) + (size_t)l * 2 * 36 * 1024; wr_[n * 1024 + k] = (bf16_t)h; wr_[36 * 1024 + n * 1024 + k] = (bf16_t)f2bf(rem); }
        for (int i = gtid; i < 2 * 36; i += NGT) { const int l = i / 36, n = i % 36; ((float*)(ws + WS_BR))[l * 64 + n] = n < 32 ? ((const float*)args.in[I_REB])[l * NE + n] : ((const float*)args.in[I_RGB])[l * 4 + n - 32]; }
        for (int i = gtid; i < T * 32; i += NGT) { const int t = i >> 5, f = i & 31; const float inv = powf(10000.f, -(float)f / 32.f); const float ang = (float)pos[t] * inv; float s, c; sincosf(ang, &s, &c); ((f32x2*)(ws + WS_CS64))[i] = (f32x2){c, s}; }
        for (int i = gtid; i < T * 16; i += NGT) { const int t = i >> 4, f = i & 15; const float inv = powf(10000.f, -(float)f / 16.f); const float ang = (float)pos[t] * inv; float s, c; sincosf(ang, &s, &c); ((f32x2*)(ws + WS_CS32))[i] = (f32x2){c, s}; }
        for (int i = gtid; i < NB * NMEM * D / 4; i += NGT) { const f32x4 v = ((const f32x4*)args.in[I_MEM])[i]; ((u32x2*)(ws + WS_MEMB))[i] = (u32x2){pk2(v.x, v.y), pk2(v.z, v.w)}; }
        for (int m = gw; m < T; m += NGW) {
            const f32x4* xr = (const f32x4*)(x_in + (size_t)m * D) + lane; f32x4 v[4]; float s = 0.f;
#pragma unroll
            for (int j = 0; j < 4; ++j) { v[j] = xr[64 * j]; s += (v[j].x * v[j].x + v[j].y * v[j].y) + (v[j].z * v[j].z + v[j].w * v[j].w); }
            s = wave_sum(s);
            u32x2* o8 = (u32x2*)(XA + (size_t)m * D) + lane;
#pragma unroll
            for (int j = 0; j < 4; ++j) o8[64 * j] = (u32x2){pk2(v[j].x, v[j].y), pk2(v[j].z, v[j].w)};
            if (lane == 0) rsbase[m] = 1.0f / sqrtf(s * (1.f / D) + EPS);
        }
        SEAM(0);
    }

    if (IN(1)) {
        { pg8::Gemm g{XA, (const bf16_t*)(ws + WS_WIN0), D, D, D}; pg8::StaticOrder S; S.init(T, A_IN, G, blk);
          pg8::EpiBf16S E{(bf16_t*)(ws + WS_PROJ0), A_IN, rsbase, 0};
          pg8::gemm_phase<pg8::EpiBf16S, pg8::StaticOrder, false>(lds, g, S, E, nullptr); }
        { pg8::Gemm g{(const bf16_t*)(ws + WS_MEMB), (const bf16_t*)(ws + WS_WMKV), D, D, D}; pg8::StaticOrder S; S.init(NB * NMEM, D, G, blk);
          pg8::EpiBf16S E{(bf16_t*)(ws + WS_KVM), D, nullptr, 0};
          pg8::gemm_phase<pg8::EpiBf16S, pg8::StaticOrder, false>(lds, g, S, E, nullptr); }
        SEAM(1);
    }

    if (IN(2)) {
        const bf16_t* proj = (const bf16_t*)(ws + WS_PROJ0);
        LAS bf16_t* KT = (LAS bf16_t*)lds; LAS bf16_t* VT = (LAS bf16_t*)(lds + 64 * 136 * 2);
        float* Ut = (float*)(ws + WS_UT);
        const int j = tid >> 2, c = tid & 3;
        for (int u = blk; u < NB * NCH * NH; u += G) {
            const int h = u % NH, bn = u / NH, n = bn % NCH, b = bn / NCH;
            const int t = b * SEQ + n * RCH + j;
            const float lg = log_gamma_h(h);
            const bf16_t* pr = proj + (size_t)t * A_IN;
            const u32x4 ka = *(const u32x4*)(pr + MAINW + h * 64 + 8 * c), kb = *(const u32x4*)(pr + MAINW + h * 64 + 32 + 8 * c);
            const u32x4 va = *(const u32x4*)(pr + 2 * MAINW + h * 64 + 8 * c), vb = *(const u32x4*)(pr + 2 * MAINW + h * 64 + 32 + 8 * c);
            const float sc = 0.125f * __expf(lg * (float)(RCH - 1 - j));
#pragma unroll
            for (int e = 0; e < 8; ++e) { const unsigned wa = ka[e >> 1], wb = kb[e >> 1]; const float x1 = (e & 1) ? bfhi(wa) : bflo(wa), x2 = (e & 1) ? bfhi(wb) : bflo(wb);
                const f32x2 cs = cs64[(size_t)t * 32 + 8 * c + e];
                KT[(8 * c + e) * 136 + j] = (bf16_t)f2bf((x1 * cs.x - x2 * cs.y) * sc); KT[(32 + 8 * c + e) * 136 + j] = (bf16_t)f2bf((x2 * cs.x + x1 * cs.y) * sc);
                const unsigned ua = va[e >> 1], ub = vb[e >> 1];
                VT[(8 * c + e) * 136 + j] = (bf16_t)((e & 1) ? (ua >> 16) : (ua & 0xffffu)); VT[(32 + 8 * c + e) * 136 + j] = (bf16_t)((e & 1) ? (ub >> 16) : (ub & 0xffffu)); }
            __syncthreads();
            const int r16 = lane & 15, q4 = lane >> 4, mt = wave >> 1;
            f32x4 acc2[2] = {(f32x4){0.f, 0.f, 0.f, 0.f}, (f32x4){0.f, 0.f, 0.f, 0.f}};
#pragma unroll
            for (int ks = 0; ks < 4; ++ks) { const bf16x8 a = *(const LAS bf16x8*)(VT + (16 * mt + r16) * 136 + 32 * ks + 8 * q4);
#pragma unroll
                for (int q = 0; q < 2; ++q) { const int nt = 2 * (wave & 1) + q; const bf16x8 bb = *(const LAS bf16x8*)(KT + (16 * nt + r16) * 136 + 32 * ks + 8 * q4); acc2[q] = MFMA16(a, bb, acc2[q]); } }
            float* up = Ut + (size_t)u * 4096;
#pragma unroll
            for (int q = 0; q < 2; ++q) { const int nt = 2 * (wave & 1) + q;
#pragma unroll
                for (int r = 0; r < 4; ++r) up[(16 * mt + 4 * q4 + r) * 64 + 16 * nt + r16] = acc2[q][r]; }
            __syncthreads();
        }
        SEAM(2);
    }

    if (IN(3)) {
        const float* Ut = (const float*)(ws + WS_UT); bf16_t* Rt = (bf16_t*)(ws + WS_RT);
        for (int i = gtid; i < NB * NH * 4096; i += NGT) { const int bh = i >> 12, e = i & 4095, b = bh / NH, h = bh % NH;
            const float dC = __expf(log_gamma_h(h) * (float)RCH); float R = 0.f;
            for (int n = 0; n < NCH; ++n) { const size_t u = (size_t)((b * NCH + n) * NH + h); Rt[u * 4096 + e] = (bf16_t)f2bf(R); R = dC * R + Ut[u * 4096 + e]; } }
        SEAM(3);
    }

    auto mem_attn_unit = [&](int u, int l, const bf16_t* qsrc, int ldq, int qcol) {
        const int qblk = u & 7, head = (u >> 3) & 3, b = u >> 5;
        LAS bf16_t* Kn = (LAS bf16_t*)lds; LAS bf16_t* VTm = (LAS bf16_t*)(lds + 256 * 72 * 2);
        const bf16_t* kvm = (const bf16_t*)(ws + WS_KVM);
        const float* kg = (const float*)args.in[I_MKN] + l * 64; const float* qg = (const float*)args.in[I_MQN] + l * 64;
        { const int key = tid >> 1, half = tid & 1; const bf16_t* kr = kvm + (size_t)(b * NMEM + key) * D + l * 512 + head * 64 + 32 * half;
          u32x4 kk[4], vv[4]; float ss = 0.f;
#pragma unroll
          for (int i = 0; i < 4; ++i) { kk[i] = *(const u32x4*)(kr + 8 * i); vv[i] = *(const u32x4*)(kr + 256 + 8 * i); }
#pragma unroll
          for (int i = 0; i < 4; ++i)
#pragma unroll
              for (int e = 0; e < 4; ++e) { const float a = bflo(kk[i][e]), bq = bfhi(kk[i][e]); ss += a * a + bq * bq; }
          ss += __shfl_xor(ss, 1); const float rstd = 1.0f / sqrtf(ss * (1.f / 64.f) + EPS);
#pragma unroll
          for (int i = 0; i < 4; ++i) { u32x4 o;
#pragma unroll
              for (int e = 0; e < 4; ++e) { const int d = 32 * half + 8 * i + 2 * e; o[e] = pk2(bflo(kk[i][e]) * rstd * kg[d], bfhi(kk[i][e]) * rstd * kg[d + 1]); }
              *(LAS u32x4*)(Kn + key * 72 + 32 * half + 8 * i) = o;
#pragma unroll
              for (int e = 0; e < 4; ++e) { const int d = 32 * half + 8 * i + 2 * e; VTm[d * 264 + key] = (bf16_t)(vv[i][e] & 0xffffu); VTm[(d + 1) * 264 + key] = (bf16_t)(vv[i][e] >> 16); } } }
        __syncthreads();
        const int r16 = lane & 15, q4 = lane >> 4;
        bf16_t* A2 = XA;
        for (int sub = 0; sub < 4; ++sub) {
            const int t = b * SEQ + qblk * 512 + sub * 128 + 16 * wave + r16;
            const bf16_t* qr = qsrc + (size_t)t * ldq + qcol + head * 64;
            const u32x4 q0 = *(const u32x4*)(qr + 8 * q4), q1 = *(const u32x4*)(qr + 32 + 8 * q4);
            float ss = 0.f;
#pragma unroll
            for (int e = 0; e < 4; ++e) { float a = bflo(q0[e]), bq = bfhi(q0[e]); ss += a * a + bq * bq; a = bflo(q1[e]); bq = bfhi(q1[e]); ss += a * a + bq * bq; }
            ss += __shfl_xor(ss, 16); ss += __shfl_xor(ss, 32);
            const float qs = (1.0f / sqrtf(ss * (1.f / 64.f) + EPS)) * (0.125f * 1.4426950408889634f);
            u32x4 qa, qb;
#pragma unroll
            for (int e = 0; e < 4; ++e) { const int d0 = 8 * q4 + 2 * e; qa[e] = pk2(bflo(q0[e]) * qs * qg[d0], bfhi(q0[e]) * qs * qg[d0 + 1]); qb[e] = pk2(bflo(q1[e]) * qs * qg[32 + d0], bfhi(q1[e]) * qs * qg[32 + d0 + 1]); }
            const bf16x8 qf0 = __builtin_bit_cast(bf16x8, qa), qf1 = __builtin_bit_cast(bf16x8, qb);
            f32x4 o[4] = {(f32x4){0.f, 0.f, 0.f, 0.f}, (f32x4){0.f, 0.f, 0.f, 0.f}, (f32x4){0.f, 0.f, 0.f, 0.f}, (f32x4){0.f, 0.f, 0.f, 0.f}};
            float mrow = -INFINITY, ls = 0.f;
#pragma unroll 1
            for (int kc = 0; kc < 4; ++kc) {
                f32x4 st[4]; float mx = -INFINITY;
#pragma unroll
                for (int k4 = 0; k4 < 4; ++k4) { const int kt = 4 * kc + k4; f32x4 a = (f32x4){0.f, 0.f, 0.f, 0.f};
                    a = MFMA16(*(const LAS bf16x8*)(Kn + (16 * kt + r16) * 72 + 8 * q4), qf0, a);
                    a = MFMA16(*(const LAS bf16x8*)(Kn + (16 * kt + r16) * 72 + 32 + 8 * q4), qf1, a);
                    st[k4] = a; mx = fmaxf(mx, fmaxf(fmaxf(a[0], a[1]), fmaxf(a[2], a[3]))); }
                mx = fmaxf(mx, __shfl_xor(mx, 16)); mx = fmaxf(mx, __shfl_xor(mx, 32));
                const float mnew = fmaxf(mrow, mx), alpha = exp2f(mrow - mnew); mrow = mnew;
                float ps = 0.f;
#pragma unroll
                for (int k4 = 0; k4 < 4; ++k4)
#pragma unroll
                    for (int r = 0; r < 4; ++r) { st[k4][r] = exp2f(st[k4][r] - mnew); ps += st[k4][r]; }
                ls = ls * alpha + ps;
#pragma unroll
                for (int dt = 0; dt < 4; ++dt) o[dt] = o[dt] * alpha;
#pragma unroll
                for (int k2 = 0; k2 < 2; ++k2) { const int kk2 = 2 * kc + k2; u32x4 pw; pw.x = pk2(st[2 * k2][0], st[2 * k2][1]); pw.y = pk2(st[2 * k2][2], st[2 * k2][3]); pw.z = pk2(st[2 * k2 + 1][0], st[2 * k2 + 1][1]); pw.w = pk2(st[2 * k2 + 1][2], st[2 * k2 + 1][3]);
                    const bf16x8 pf = __builtin_bit_cast(bf16x8, pw);
#pragma unroll
                    for (int dt = 0; dt < 4; ++dt) { const LAS bf16_t* vp = VTm + (16 * dt + r16) * 264 + 32 * kk2 + 4 * q4; const u32x2 v0 = *(const LAS u32x2*)vp, v1 = *(const LAS u32x2*)(vp + 16);
                        const u32x4 vw = (u32x4){v0.x, v0.y, v1.x, v1.y}; o[dt] = MFMA16(__builtin_bit_cast(bf16x8, vw), pf, o[dt]); } }
            }
            ls += __shfl_xor(ls, 16); ls += __shfl_xor(ls, 32);
            const float il = 1.0f / ls;
#pragma unroll
            for (int dt = 0; dt < 4; ++dt) { const u32x2 w = (u32x2){pk2(o[dt][0] * il, o[dt][1] * il), pk2(o[dt][2] * il, o[dt][3] * il)}; *(u32x2*)(A2 + (size_t)t * D + MAINW + head * 64 + 16 * dt + 4 * q4) = w; }
        }
        __syncthreads();
    };

    if (IN(4)) {
        const bf16_t* proj = (const bf16_t*)(ws + WS_PROJ0); const bf16_t* Rt = (const bf16_t*)(ws + WS_RT);
        LAS bf16_t* Qs = (LAS bf16_t*)lds; LAS bf16_t* Ks = (LAS bf16_t*)(lds + 128 * 72 * 2); LAS bf16_t* VT = (LAS bf16_t*)(lds + 2 * 128 * 72 * 2); LAS bf16_t* Rs = (LAS bf16_t*)(lds + 2 * 128 * 72 * 2 + 64 * 136 * 2);
        const float* gn = (const float*)args.in[I_RGN];
        const int j = tid >> 2, c = tid & 3;
        for (int u = blk; u < NB * NCH * NH; u += G) {
            const int h = u % NH, bn = u / NH, n = bn % NCH, b = bn / NCH;
            const int t = b * SEQ + n * RCH + j;
            const float lg = log_gamma_h(h), lg2 = lg * 1.4426950408889634f;
            const bf16_t* pr = proj + (size_t)t * A_IN;
            { const u32x4 qa = *(const u32x4*)(pr + h * 64 + 8 * c), qb = *(const u32x4*)(pr + h * 64 + 32 + 8 * c);
              const u32x4 ka = *(const u32x4*)(pr + MAINW + h * 64 + 8 * c), kb = *(const u32x4*)(pr + MAINW + h * 64 + 32 + 8 * c);
              const u32x4 va = *(const u32x4*)(pr + 2 * MAINW + h * 64 + 8 * c), vb = *(const u32x4*)(pr + 2 * MAINW + h * 64 + 32 + 8 * c);
              float q1[8], q2[8], k1[8], k2[8];
#pragma unroll
              for (int e = 0; e < 8; ++e) { const f32x2 cs = cs64[(size_t)t * 32 + 8 * c + e];
                  const float xq1 = (e & 1) ? bfhi(qa[e >> 1]) : bflo(qa[e >> 1]), xq2 = (e & 1) ? bfhi(qb[e >> 1]) : bflo(qb[e >> 1]);
                  const float xk1 = (e & 1) ? bfhi(ka[e >> 1]) : bflo(ka[e >> 1]), xk2 = (e & 1) ? bfhi(kb[e >> 1]) : bflo(kb[e >> 1]);
                  q1[e] = xq1 * cs.x - xq2 * cs.y; q2[e] = xq2 * cs.x + xq1 * cs.y; k1[e] = (xk1 * cs.x - xk2 * cs.y) * 0.125f; k2[e] = (xk2 * cs.x + xk1 * cs.y) * 0.125f;
                  VT[(8 * c + e) * 136 + j] = (bf16_t)((e & 1) ? (va[e >> 1] >> 16) : (va[e >> 1] & 0xffffu)); VT[(32 + 8 * c + e) * 136 + j] = (bf16_t)((e & 1) ? (vb[e >> 1] >> 16) : (vb[e >> 1] & 0xffffu)); }
              *(LAS u32x4*)(Qs + j * 72 + 8 * c) = (u32x4){pk2(q1[0], q1[1]), pk2(q1[2], q1[3]), pk2(q1[4], q1[5]), pk2(q1[6], q1[7])};
              *(LAS u32x4*)(Qs + j * 72 + 32 + 8 * c) = (u32x4){pk2(q2[0], q2[1]), pk2(q2[2], q2[3]), pk2(q2[4], q2[5]), pk2(q2[6], q2[7])};
              *(LAS u32x4*)(Ks + j * 72 + 8 * c) = (u32x4){pk2(k1[0], k1[1]), pk2(k1[2], k1[3]), pk2(k1[4], k1[5]), pk2(k1[6], k1[7])};
              *(LAS u32x4*)(Ks + j * 72 + 32 + 8 * c) = (u32x4){pk2(k2[0], k2[1]), pk2(k2[2], k2[3]), pk2(k2[4], k2[5]), pk2(k2[6], k2[7])};
              *(LAS u32x4*)(Rs + (tid >> 3) * 72 + 8 * (tid & 7)) = *(const u32x4*)(Rt + (size_t)u * 4096 + (tid >> 3) * 64 + 8 * (tid & 7)); }
            __syncthreads();
            const int r16 = lane & 15, q4 = lane >> 4, w = wave, i_loc = 16 * w + r16;
            const bf16x8 qf0 = *(const LAS bf16x8*)(Qs + i_loc * 72 + 8 * q4), qf1 = *(const LAS bf16x8*)(Qs + i_loc * 72 + 32 + 8 * q4);
            f32x4 o[4] = {(f32x4){0.f, 0.f, 0.f, 0.f}, (f32x4){0.f, 0.f, 0.f, 0.f}, (f32x4){0.f, 0.f, 0.f, 0.f}, (f32x4){0.f, 0.f, 0.f, 0.f}};
            for (int kk2 = 0; kk2 <= (w >> 1); ++kk2) {
                f32x4 s0 = (f32x4){0.f, 0.f, 0.f, 0.f}, s1 = (f32x4){0.f, 0.f, 0.f, 0.f};
                s0 = MFMA16(*(const LAS bf16x8*)(Ks + (32 * kk2 + r16) * 72 + 8 * q4), qf0, s0); s0 = MFMA16(*(const LAS bf16x8*)(Ks + (32 * kk2 + r16) * 72 + 32 + 8 * q4), qf1, s0);
                const bool two = (2 * kk2 + 1) <= w;
                if (two) { s1 = MFMA16(*(const LAS bf16x8*)(Ks + (32 * kk2 + 16 + r16) * 72 + 8 * q4), qf0, s1); s1 = MFMA16(*(const LAS bf16x8*)(Ks + (32 * kk2 + 16 + r16) * 72 + 32 + 8 * q4), qf1, s1); }
                float p0[4], p1[4];
#pragma unroll
                for (int r = 0; r < 4; ++r) { const int d0 = i_loc - (32 * kk2 + 4 * q4 + r), d1 = d0 - 16;
                    p0[r] = d0 >= 0 ? s0[r] * exp2f(lg2 * (float)d0) : 0.f; p1[r] = (two && d1 >= 0) ? s1[r] * exp2f(lg2 * (float)d1) : 0.f; }
                const u32x4 pw = (u32x4){pk2(p0[0], p0[1]), pk2(p0[2], p0[3]), pk2(p1[0], p1[1]), pk2(p1[2], p1[3])}; const bf16x8 pf = __builtin_bit_cast(bf16x8, pw);
#pragma unroll
                for (int dt = 0; dt < 4; ++dt) { const LAS bf16_t* vp = VT + (16 * dt + r16) * 136 + 32 * kk2 + 4 * q4; const u32x2 v0 = *(const LAS u32x2*)vp, v1 = *(const LAS u32x2*)(vp + 16);
                    const u32x4 vw = (u32x4){v0.x, v0.y, v1.x, v1.y}; o[dt] = MFMA16(__builtin_bit_cast(bf16x8, vw), pf, o[dt]); }
            }
            f32x4 xc[4];
#pragma unroll
            for (int dt = 0; dt < 4; ++dt) { f32x4 a = (f32x4){0.f, 0.f, 0.f, 0.f}; a = MFMA16(*(const LAS bf16x8*)(Rs + (16 * dt + r16) * 72 + 8 * q4), qf0, a); a = MFMA16(*(const LAS bf16x8*)(Rs + (16 * dt + r16) * 72 + 32 + 8 * q4), qf1, a); xc[dt] = a; }
            const float gq = exp2f(lg2 * (float)(i_loc + 1));
            float s1 = 0.f;
#pragma unroll
            for (int dt = 0; dt < 4; ++dt)
#pragma unroll
                for (int r = 0; r < 4; ++r) { o[dt][r] += gq * xc[dt][r]; s1 += o[dt][r]; }
            s1 += __shfl_xor(s1, 16); s1 += __shfl_xor(s1, 32);
            const float mean = s1 * (1.f / 64.f); float s2 = 0.f;
#pragma unroll
            for (int dt = 0; dt < 4; ++dt)
#pragma unroll
                for (int r = 0; r < 4; ++r) { o[dt][r] -= mean; s2 += o[dt][r] * o[dt][r]; }
            s2 += __shfl_xor(s2, 16); s2 += __shfl_xor(s2, 32);
            const float rstd = 1.0f / sqrtf(s2 * (1.f / 64.f) + EPS);
            const int tq = b * SEQ + n * RCH + i_loc;
#pragma unroll
            for (int dt = 0; dt < 4; ++dt) { const int dv = 16 * dt + 4 * q4; const u32x2 gg = *(const u32x2*)(proj + (size_t)tq * A_IN + 3 * MAINW + h * 64 + dv); const f32x4 gv = *(const f32x4*)(gn + h * 64 + dv);
                const float y0 = o[dt][0] * rstd * gv[0] * siluf(bflo(gg.x)), y1 = o[dt][1] * rstd * gv[1] * siluf(bfhi(gg.x)), y2 = o[dt][2] * rstd * gv[2] * siluf(bflo(gg.y)), y3 = o[dt][3] * rstd * gv[3] * siluf(bfhi(gg.y));
                *(u32x2*)(XA + (size_t)tq * D + h * 64 + dv) = (u32x2){pk2(y0, y1), pk2(y2, y3)}; }
            __syncthreads();
        }
        for (int u = blk; u < 256; u += G) mem_attn_unit(u, 0, proj, A_IN, 4 * MAINW);
        SEAM(4);
    }

    if (IN(5)) {
        pg8::Gemm g{XA, (const bf16_t*)(ws + WS_WOUT), D, D, D}; pg8::StaticOrder S; S.init(T, D, G, blk);
        pg8::EpiF32Res E{out, x_in, D};
        pg8::gemm_phase<pg8::EpiF32Res, pg8::StaticOrder, false>(lds, g, S, E, nullptr);
        SEAM(5);
    }

    auto route_phase = [&](int l, float* rs) {
        const float* src = out;
        LAS bf16_t* Wh = (LAS bf16_t*)lds; LAS bf16_t* Wl = (LAS bf16_t*)(lds + 36 * 1032 * 2);
        LAS int* lcnt = (LAS int*)(lds + 152000); LAS int* gbase = lcnt + 32; LAS unsigned* rowER = (LAS unsigned*)(lds + 152000 + 256); LAS float* rowW = (LAS float*)(lds + 152000 + 256 + 1024);
        unsigned* cnt = ctl + CW_CNT + 64 * l; int* list = (int*)(ws + WS_LIST);
        unsigned* tker = (unsigned*)(ws + WS_TKER) + (size_t)l * T * 2; float* tkw = (float*)(ws + WS_TKW) + (size_t)l * T * 2;
        const bf16_t* wrg = (const bf16_t*)(ws + WS_WR) + (size_t)l * 2 * 36 * 1024; const float* br = (const float*)(ws + WS_BR) + l * 64;
        for (int chunk = blk; chunk < T / 128; chunk += G) {
            __syncthreads();
            for (int i = tid; i < 2 * 36 * 128; i += 512) { const int hl = i / (36 * 128), q = i % (36 * 128), n = q / 128, c8 = q % 128; *(LAS u32x4*)((hl ? Wl : Wh) + n * 1032 + 8 * c8) = *(const u32x4*)(wrg + (size_t)hl * 36 * 1024 + n * 1024 + 8 * c8); }
            if (tid < 32) lcnt[tid] = 0;
            __syncthreads();
            const int r16 = lane & 15, q4 = lane >> 4; const int rl = 16 * wave + r16, t = chunk * 128 + rl;
            const float* xr = src + (size_t)t * D; bf16_t* xo = XA + (size_t)t * D;
            f32x4 acc[3] = {(f32x4){0.f, 0.f, 0.f, 0.f}, (f32x4){0.f, 0.f, 0.f, 0.f}, (f32x4){0.f, 0.f, 0.f, 0.f}}; float ss = 0.f;
#pragma unroll 4
            for (int ks = 0; ks < 32; ++ks) { const f32x4 a = *(const f32x4*)(xr + 32 * ks + 8 * q4), bq = *(const f32x4*)(xr + 32 * ks + 8 * q4 + 4);
                ss += (a.x * a.x + a.y * a.y) + (a.z * a.z + a.w * a.w) + (bq.x * bq.x + bq.y * bq.y) + (bq.z * bq.z + bq.w * bq.w);
                const float v[8] = {a.x, a.y, a.z, a.w, bq.x, bq.y, bq.z, bq.w}; unsigned hh[8], ll[8];
#pragma unroll
                for (int e = 0; e < 8; ++e) { hh[e] = f2bf(v[e]); ll[e] = f2bf(v[e] - bf2f((unsigned short)hh[e])); }
                const u32x4 hw = (u32x4){hh[0] | (hh[1] << 16), hh[2] | (hh[3] << 16), hh[4] | (hh[5] << 16), hh[6] | (hh[7] << 16)}, lw = (u32x4){ll[0] | (ll[1] << 16), ll[2] | (ll[3] << 16), ll[4] | (ll[5] << 16), ll[6] | (ll[7] << 16)};
                *(u32x4*)(xo + 32 * ks + 8 * q4) = hw;
                const bf16x8 xh = __builtin_bit_cast(bf16x8, hw), xl = __builtin_bit_cast(bf16x8, lw);
#pragma unroll
                for (int nt = 0; nt < 3; ++nt) { const int nrow = (16 * nt + r16) < 36 ? (16 * nt + r16) : 35;
                    const bf16x8 wh = *(const LAS bf16x8*)(Wh + nrow * 1032 + 32 * ks + 8 * q4), wl = *(const LAS bf16x8*)(Wl + nrow * 1032 + 32 * ks + 8 * q4);
                    acc[nt] = MFMA16(wh, xh, acc[nt]); acc[nt] = MFMA16(wh, xl, acc[nt]); acc[nt] = MFMA16(wl, xh, acc[nt]); } }
            ss += __shfl_xor(ss, 16); ss += __shfl_xor(ss, 32);
            const float rstd = 1.0f / sqrtf(ss * (1.f / D) + EPS);
            if (q4 == 0) rs[t] = rstd;
            __syncthreads();
            LAS float* lg = (LAS float*)lds;
#pragma unroll
            for (int nt = 0; nt < 3; ++nt)
#pragma unroll
                for (int r = 0; r < 4; ++r) { const int n = 16 * nt + 4 * q4 + r; if (n < 36) lg[rl * 40 + n] = acc[nt][r] * rstd + br[n]; }
            LDS_WAIT(); asm volatile("" ::: "memory");
            if (q4 == 0) {
                const LAS float* L = lg + rl * 40;
                int grp = 0; float gm = L[32];
#pragma unroll
                for (int gi = 1; gi < 4; ++gi) if (L[32 + gi] > gm) { gm = L[32 + gi]; grp = gi; }
                float gs = 0.f;
#pragma unroll
                for (int gi = 0; gi < 4; ++gi) gs += __expf(L[32 + gi] - gm);
                const float pg = 1.0f / gs;
                int i0 = 0; float m0 = L[8 * grp];
#pragma unroll
                for (int ji = 1; ji < 8; ++ji) { const float v = L[8 * grp + ji]; if (v > m0) { m0 = v; i0 = ji; } }
                int i1 = -1; float m1 = -INFINITY;
#pragma unroll
                for (int ji = 0; ji < 8; ++ji) { const float v = L[8 * grp + ji]; if (ji != i0 && v > m1) { m1 = v; i1 = ji; } }
                const float e1 = __expf(m1 - m0); const float w0 = pg / (1.f + e1), w1 = pg * e1 / (1.f + e1);
                const int ex0 = grp * 8 + i0, ex1 = grp * 8 + i1;
                const int lr0 = atomicAdd((int*)(lcnt + ex0), 1), lr1 = atomicAdd((int*)(lcnt + ex1), 1);
                rowER[rl * 2] = ((unsigned)ex0 << 16) | (unsigned)lr0; rowER[rl * 2 + 1] = ((unsigned)ex1 << 16) | (unsigned)lr1; rowW[rl * 2] = w0; rowW[rl * 2 + 1] = w1;
            }
            __syncthreads();
            if (tid < 32) gbase[tid] = (int)__hip_atomic_fetch_add(cnt + tid, (unsigned)lcnt[tid], RLX_AGENT);
            __syncthreads();
            if (tid < 256) { const int row = tid >> 1, k = tid & 1; const unsigned er = rowER[row * 2 + k]; const int e = er >> 16, rank = gbase[e] + (int)(er & 0xffffu); const int tt = chunk * 128 + row;
                list[(size_t)e * T + rank] = tt; tker[(size_t)tt * 2 + k] = ((unsigned)e << 16) | (unsigned)rank; tkw[(size_t)tt * 2 + k] = rowW[row * 2 + k]; }
        }
    };
    auto build_tb = [&](int l) {
        LAS int* tb = (LAS int*)(lds + L_MISC); LAS int* cntL = (LAS int*)(lds + L_MISC + 256);
        __syncthreads();
        if (tid == 0) { int a = 0; for (int e = 0; e < NE; ++e) { const int c = (int)__hip_atomic_load(ctl + CW_CNT + 64 * l + e, RLX_AGENT); cntL[e] = c; tb[e] = a; a += (c + 255) >> 8; } tb[32] = a; }
        __syncthreads();
    };
    auto moe_gateup = [&](int l, const float* rs) {
        build_tb(l);
        LAS int* tb = (LAS int*)(lds + L_MISC); LAS int* cntL = (LAS int*)(lds + L_MISC + 256); LAS int* tokL = (LAS int*)(lds + L_MISC + 1024); LAS float* rsL = (LAS float*)(lds + L_MISC + 4096);
        const int* list = (const int*)(ws + WS_LIST);
        pg8::MoeOrder S{tb, 2, G, blk};
        { pg8::Unit u; for (int i = 0; i < 3 && S.next(i, u); ++i) { const int e = u.pn >> 1; if (tid < 256) { int rank = (u.pm - tb[e]) * 256 + tid; if (rank >= cntL[e]) rank = 0; const int tk = list[(size_t)e * T + rank]; tokL[i * 256 + tid] = tk; rsL[i * 256 + tid] = rs[tk]; } } }
        __syncthreads();
        pg8::Gemm g{XA, (const bf16_t*)(ws + WS_WEXP + (size_t)l * WEXP_L), D, D, D};
        pg8::EpiSwiGLU E{(bf16_t*)(ws + WS_HID), rsL};
        pg8::gemm_phase<pg8::EpiSwiGLU, pg8::MoeOrder, true>(lds, g, S, E, tokL);
    };
    auto moe_down = [&](int l) {
        build_tb(l);
        LAS int* tb = (LAS int*)(lds + L_MISC);
        pg8::MoeOrder S{tb, 4, G, blk};
        pg8::Gemm g{(const bf16_t*)(ws + WS_HID), (const bf16_t*)(ws + WS_WEXP + (size_t)l * WEXP_L + WEXP_DN), DE, DE, DE};
        pg8::EpiBf16S E{(bf16_t*)(ws + WS_YS), D, nullptr, 4};
        pg8::gemm_phase<pg8::EpiBf16S, pg8::MoeOrder, false>(lds, g, S, E, nullptr);
    };
    auto combine_phase = [&](int l, float* rs) {
        build_tb(l);
        LAS int* tb = (LAS int*)(lds + L_MISC);
        const unsigned* tker = (const unsigned*)(ws + WS_TKER) + (size_t)l * T * 2; const float* tkw = (const float*)(ws + WS_TKW) + (size_t)l * T * 2; const bf16_t* ys = (const bf16_t*)(ws + WS_YS);
        for (int m = gw; m < T; m += NGW) {
            const unsigned er0 = tker[(size_t)m * 2], er1 = tker[(size_t)m * 2 + 1]; const float w0 = tkw[(size_t)m * 2], w1 = tkw[(size_t)m * 2 + 1];
            const size_t s0 = (size_t)tb[er0 >> 16] * 256 + (er0 & 0xffffu), s1 = (size_t)tb[er1 >> 16] * 256 + (er1 & 0xffffu);
            f32x4* xr = (f32x4*)(out + (size_t)m * D) + lane; const u32x2* y0 = (const u32x2*)(ys + s0 * D) + lane; const u32x2* y1 = (const u32x2*)(ys + s1 * D) + lane;
            f32x4 v[4]; float s = 0.f;
#pragma unroll
            for (int j = 0; j < 4; ++j) { v[j] = xr[64 * j]; const u32x2 a = y0[64 * j], bq = y1[64 * j];
                v[j].x += w0 * bflo(a.x) + w1 * bflo(bq.x); v[j].y += w0 * bfhi(a.x) + w1 * bfhi(bq.x); v[j].z += w0 * bflo(a.y) + w1 * bflo(bq.y); v[j].w += w0 * bfhi(a.y) + w1 * bfhi(bq.y);
                s += (v[j].x * v[j].x + v[j].y * v[j].y) + (v[j].z * v[j].z + v[j].w * v[j].w); xr[64 * j] = v[j]; }
            if (rs) { s = wave_sum(s); u32x2* o8 = (u32x2*)(XA + (size_t)m * D) + lane;
#pragma unroll
                for (int j = 0; j < 4; ++j) o8[64 * j] = (u32x2){pk2(v[j].x, v[j].y), pk2(v[j].z, v[j].w)};
                if (lane == 0) rs[m] = 1.0f / sqrtf(s * (1.f / D) + EPS); }
        }
    };

    if (IN(6)) { route_phase(0, rsbase + T); SEAM(6); }
    if (IN(7)) { moe_gateup(0, rsbase + T); SEAM(7); }
    if (IN(8)) { moe_down(0); SEAM(8); }
    if (IN(9)) { combine_phase(0, rsbase + 2 * T); SEAM(9); }

    if (IN(10)) {
        pg8::Gemm g{XA, (const bf16_t*)(ws + WS_WIN1), D, D, D}; pg8::StaticOrder S; S.init(T, D, G, blk);
        pg8::EpiBf16S E{(bf16_t*)(ws + WS_PROJ1), D, rsbase + 2 * T, 0};
        pg8::gemm_phase<pg8::EpiBf16S, pg8::StaticOrder, false>(lds, g, S, E, nullptr);
        SEAM(10);
    }
    if (IN(11)) {
        { pg8::Gemm g{(const bf16_t*)(ws + WS_PROJ1), (const bf16_t*)(ws + WS_WUKV), D, KVL, KVL}; pg8::StaticOrder S; S.init(T, LDKV, G, blk);
          pg8::EpiBf16S E{(bf16_t*)(ws + WS_KV), LDKV, nullptr, 0};
          pg8::gemm_phase<pg8::EpiBf16S, pg8::StaticOrder, false>(lds, g, S, E, nullptr); }
        { pg8::Gemm g{(const bf16_t*)(ws + WS_PROJ1) + KVL, (const bf16_t*)(ws + WS_WUQ), D, QL, QL}; pg8::StaticOrder S; S.init(T, LDQ, G, blk);
          pg8::EpiBf16S E{(bf16_t*)(ws + WS_Q), LDQ, nullptr, 0};
          pg8::gemm_phase<pg8::EpiBf16S, pg8::StaticOrder, false>(lds, g, S, E, nullptr); }
        SEAM(11);
    }
    if (IN(12)) {
        const bf16_t* proj1 = (const bf16_t*)(ws + WS_PROJ1); bf16_t* KV = (bf16_t*)(ws + WS_KV); bf16_t* Qb = (bf16_t*)(ws + WS_Q); bf16_t* Vt = (bf16_t*)(ws + WS_VT);
        const float* kg = (const float*)args.in[I_KN]; const float* qg = (const float*)args.in[I_QN];
        LAS bf16_t* Vtile = (LAS bf16_t*)lds;
        const float QSC = 0.10206207261596575f * 1.4426950408889634f;
        for (int tl = blk; tl < T / 64; tl += G) {
            const int hh = lane >> 2, s = lane & 3; const bool act = lane < 48;
            for (int rr = 0; rr < 8; ++rr) {
                const int tloc = 8 * wave + rr, t = tl * 64 + tloc; const bf16_t* p1 = proj1 + (size_t)t * D;
                const u32x2 cw = *(const u32x2*)(p1 + 4 * lane); float skv = bflo(cw.x) * bflo(cw.x) + bfhi(cw.x) * bfhi(cw.x) + bflo(cw.y) * bflo(cw.y) + bfhi(cw.y) * bfhi(cw.y);
                float sq = 0.f; if (act) { const u32x4 qw = *(const u32x4*)(p1 + KVL + 8 * lane);
#pragma unroll
                    for (int e = 0; e < 4; ++e) sq += bflo(qw[e]) * bflo(qw[e]) + bfhi(qw[e]) * bfhi(qw[e]); }
                skv = wave_sum(skv); sq = wave_sum(sq);
                const float rkv = 1.0f / sqrtf(skv * (1.f / KVL) + EPS), rq = 1.0f / sqrtf(sq * (1.f / QL) + EPS);
                if (act) {
                    bf16_t* kvr = KV + (size_t)t * LDKV + hh * 128;
                    const u32x4 kn0 = *(const u32x4*)(kvr + 16 * s), kn1 = *(const u32x4*)(kvr + 16 * s + 8), vv0 = *(const u32x4*)(kvr + 64 + 16 * s), vv1 = *(const u32x4*)(kvr + 64 + 16 * s + 8);
                    const u32x2 ra = *(const u32x2*)(p1 + 896 + 4 * s), rb = *(const u32x2*)(p1 + 912 + 4 * s);
                    float kn[16], ar[4], br2[4]; float ssk = 0.f;
#pragma unroll
                    for (int e = 0; e < 4; ++e) { kn[2 * e] = bflo(kn0[e]) * rkv; kn[2 * e + 1] = bfhi(kn0[e]) * rkv; kn[8 + 2 * e] = bflo(kn1[e]) * rkv; kn[8 + 2 * e + 1] = bfhi(kn1[e]) * rkv; }
                    ar[0] = bflo(ra.x); ar[1] = bfhi(ra.x); ar[2] = bflo(ra.y); ar[3] = bfhi(ra.y); br2[0] = bflo(rb.x); br2[1] = bfhi(rb.x); br2[2] = bflo(rb.y); br2[3] = bfhi(rb.y);
#pragma unroll
                    for (int e = 0; e < 16; ++e) ssk += kn[e] * kn[e];
#pragma unroll
                    for (int e = 0; e < 4; ++e) ssk += ar[e] * ar[e] + br2[e] * br2[e];
                    ssk += __shfl_xor(ssk, 1); ssk += __shfl_xor(ssk, 2);
                    const float rk = 1.0f / sqrtf(ssk * (1.f / QKH) + EPS);
                    u32x4 o0, o1;
#pragma unroll
                    for (int e = 0; e < 4; ++e) { o0[e] = pk2(kn[2 * e] * rk * kg[16 * s + 2 * e], kn[2 * e + 1] * rk * kg[16 * s + 2 * e + 1]); o1[e] = pk2(kn[8 + 2 * e] * rk * kg[16 * s + 8 + 2 * e], kn[8 + 2 * e + 1] * rk * kg[16 * s + 8 + 2 * e + 1]); }
                    float r1[4], r2[4];
#pragma unroll
                    for (int e = 0; e < 4; ++e) { const int i = 4 * s + e; const f32x2 cs = cs32[(size_t)t * 16 + i]; const float a = ar[e] * rk * kg[64 + i], bq = br2[e] * rk * kg[80 + i]; r1[e] = a * cs.x - bq * cs.y; r2[e] = bq * cs.x + a * cs.y; }
#pragma unroll
                    for (int e = 0; e < 4; ++e) { Vtile[(hh * 64 + 16 * s + 2 * e) * 72 + tloc] = (bf16_t)f2bf(bflo(vv0[e]) * rkv); Vtile[(hh * 64 + 16 * s + 2 * e + 1) * 72 + tloc] = (bf16_t)f2bf(bfhi(vv0[e]) * rkv);
                        Vtile[(hh * 64 + 16 * s + 8 + 2 * e) * 72 + tloc] = (bf16_t)f2bf(bflo(vv1[e]) * rkv); Vtile[(hh * 64 + 16 * s + 8 + 2 * e + 1) * 72 + tloc] = (bf16_t)f2bf(bfhi(vv1[e]) * rkv); }
                    *(u32x4*)(kvr + 16 * s) = o0; *(u32x4*)(kvr + 16 * s + 8) = o1;
                    *(u32x2*)(kvr + 64 + 4 * s) = (u32x2){pk2(r1[0], r1[1]), pk2(r1[2], r1[3])}; *(u32x2*)(kvr + 80 + 4 * s) = (u32x2){pk2(r2[0], r2[1]), pk2(r2[2], r2[3])};
                    bf16_t* qr = Qb + (size_t)t * LDQ + hh * QKH;
                    const u32x4 qn0 = *(const u32x4*)(qr + 16 * s), qn1 = *(const u32x4*)(qr + 16 * s + 8); const u32x2 qa = *(const u32x2*)(qr + 64 + 4 * s), qb = *(const u32x2*)(qr + 80 + 4 * s);
                    float qn[16], qa4[4], qb4[4]; float ssq = 0.f;
#pragma unroll
                    for (int e = 0; e < 4; ++e) { qn[2 * e] = bflo(qn0[e]) * rq; qn[2 * e + 1] = bfhi(qn0[e]) * rq; qn[8 + 2 * e] = bflo(qn1[e]) * rq; qn[8 + 2 * e + 1] = bfhi(qn1[e]) * rq; }
                    qa4[0] = bflo(qa.x) * rq; qa4[1] = bfhi(qa.x) * rq; qa4[2] = bflo(qa.y) * rq; qa4[3] = bfhi(qa.y) * rq; qb4[0] = bflo(qb.x) * rq; qb4[1] = bfhi(qb.x) * rq; qb4[2] = bflo(qb.y) * rq; qb4[3] = bfhi(qb.y) * rq;
#pragma unroll
                    for (int e = 0; e < 16; ++e) ssq += qn[e] * qn[e];
#pragma unroll
                    for (int e = 0; e < 4; ++e) ssq += qa4[e] * qa4[e] + qb4[e] * qb4[e];
                    ssq += __shfl_xor(ssq, 1); ssq += __shfl_xor(ssq, 2);
                    const float rqh = (1.0f / sqrtf(ssq * (1.f / QKH) + EPS)) * QSC;
                    u32x4 p0, p1v;
#pragma unroll
                    for (int e = 0; e < 4; ++e) { p0[e] = pk2(qn[2 * e] * rqh * qg[16 * s + 2 * e], qn[2 * e + 1] * rqh * qg[16 * s + 2 * e + 1]); p1v[e] = pk2(qn[8 + 2 * e] * rqh * qg[16 * s + 8 + 2 * e], qn[8 + 2 * e + 1] * rqh * qg[16 * s + 8 + 2 * e + 1]); }
                    float t1[4], t2[4];
#pragma unroll
                    for (int e = 0; e < 4; ++e) { const int i = 4 * s + e; const f32x2 cs = cs32[(size_t)t * 16 + i]; const float a = qa4[e] * rqh * qg[64 + i], bq = qb4[e] * rqh * qg[80 + i]; t1[e] = a * cs.x - bq * cs.y; t2[e] = bq * cs.x + a * cs.y; }
                    *(u32x4*)(qr + 16 * s) = p0; *(u32x4*)(qr + 16 * s + 8) = p1v;
                    *(u32x2*)(qr + 64 + 4 * s) = (u32x2){pk2(t1[0], t1[1]), pk2(t1[2], t1[3])}; *(u32x2*)(qr + 80 + 4 * s) = (u32x2){pk2(t2[0], t2[1]), pk2(t2[2], t2[3])};
                }
            }
            __syncthreads();
            { const int b = (tl * 64) / SEQ, s0 = (tl * 64) % SEQ;
              for (int i = tid; i < 768 * 8; i += 512) { const int row = i >> 3, ch = i & 7; *(u32x4*)(Vt + ((size_t)(b * NH * 64 + row)) * SEQ + s0 + 8 * ch) = *(const LAS u32x4*)(Vtile + row * 72 + 8 * ch); } }
            __syncthreads();
        }
        SEAM(12);
    }

    if (IN(13)) {
        const bf16_t* Qb = (const bf16_t*)(ws + WS_Q); const bf16_t* KV = (const bf16_t*)(ws + WS_KV); const bf16_t* Vt = (const bf16_t*)(ws + WS_VT);
        constexpr int KSTR = 104, VSTR = 68, KBUF = 64 * KSTR * 2, VBUF = 64 * VSTR * 2;
        const int r32 = lane & 31, hi5 = lane >> 5;
        for (int pi = 0; pi < 3; ++pi) {
            const int p = blk + G * pi; if (p >= 768) break;
            const int bh = p >> 3, sidx = p & 7, b = bh / NH, h = bh % NH;
            for (int which = 0; which < 2; ++which) {
                const int qb = which ? sidx : 15 - sidx;
                const int NT = 4 * (qb + 1);
                const int trow = b * SEQ + qb * 256 + 32 * wave + r32;
                bf16x8 qf[6];
#pragma unroll
                for (int d0 = 0; d0 < 6; ++d0) qf[d0] = *(const bf16x8*)(Qb + (size_t)trow * LDQ + h * QKH + 16 * d0 + 8 * hi5);
                const int kc0 = tid, kc1 = 512 + tid; const bool k1v = kc1 < 768;
                const int kkey0 = kc0 / 12, kch0 = kc0 % 12, kkey1 = k1v ? kc1 / 12 : 0, kch1 = k1v ? kc1 % 12 : 0;
                const int vdv = tid >> 3, vch = tid & 7;
                const bf16_t* kbase = KV + (size_t)(b * SEQ) * LDKV + h * 128; const bf16_t* vbase = Vt + (size_t)(bh * 64 + vdv) * SEQ + 8 * vch;
                u32x4 kr0, kr1, vr;
                kr0 = *(const u32x4*)(kbase + (size_t)kkey0 * LDKV + 8 * kch0); kr1 = *(const u32x4*)(kbase + (size_t)kkey1 * LDKV + 8 * kch1); vr = *(const u32x4*)vbase;
                __syncthreads();
                { LAS unsigned char* kb_ = lds; LAS unsigned char* vb_ = lds + 2 * KBUF;
                  *(LAS u32x4*)(kb_ + (kkey0 * KSTR + 8 * kch0) * 2) = kr0; if (k1v) *(LAS u32x4*)(kb_ + (kkey1 * KSTR + 8 * kch1) * 2) = kr1;
                  *(LAS u32x2*)(vb_ + (vdv * VSTR + 8 * vch) * 2) = (u32x2){vr.x, vr.y}; *(LAS u32x2*)(vb_ + (vdv * VSTR + 8 * vch + 4) * 2) = (u32x2){vr.z, vr.w}; }
                __syncthreads();
                f32x16 o0, o1;
#pragma unroll
                for (int r = 0; r < 16; ++r) { o0[r] = 0.f; o1[r] = 0.f; }
                float mrow = -INFINITY, lrow = 0.f;
                for (int kt = 0; kt < NT; ++kt) {
                    const int cur = kt & 1;
                    if (kt + 1 < NT) { const size_t ko = (size_t)(64 * (kt + 1)) * LDKV; kr0 = *(const u32x4*)(kbase + ko + (size_t)kkey0 * LDKV + 8 * kch0); kr1 = *(const u32x4*)(kbase + ko + (size_t)kkey1 * LDKV + 8 * kch1); vr = *(const u32x4*)(vbase + 64 * (kt + 1)); }
                    const LAS bf16_t* Kc = (const LAS bf16_t*)(lds + cur * KBUF); const LAS bf16_t* Vc = (const LAS bf16_t*)(lds + 2 * KBUF + cur * VBUF);
                    f32x16 s0, s1;
#pragma unroll
                    for (int r = 0; r < 16; ++r) { s0[r] = 0.f; s1[r] = 0.f; }
#pragma unroll
                    for (int d0 = 0; d0 < 6; ++d0) { s0 = MFMA32(*(const LAS bf16x8*)(Kc + r32 * KSTR + 16 * d0 + 8 * hi5), qf[d0], s0); s1 = MFMA32(*(const LAS bf16x8*)(Kc + (32 + r32) * KSTR + 16 * d0 + 8 * hi5), qf[d0], s1); }
                    if (kt >= NT - 4) { const int qrel = qb * 256 + 32 * wave + r32 - 64 * kt;
#pragma unroll
                        for (int r = 0; r < 16; ++r) { const int kv = (r & 3) + 8 * (r >> 2) + 4 * hi5; if (kv > qrel) s0[r] = -INFINITY; if (kv + 32 > qrel) s1[r] = -INFINITY; } }
                    float mx = -INFINITY;
#pragma unroll
                    for (int r = 0; r < 16; ++r) mx = fmaxf(mx, fmaxf(s0[r], s1[r]));
                    mx = fmaxf(mx, __shfl_xor(mx, 32));
                    const float mnew = fmaxf(mrow, mx); const float alpha = exp2f(mrow - mnew); mrow = mnew;
                    float ps = 0.f;
#pragma unroll
                    for (int r = 0; r < 16; ++r) { s0[r] = exp2f(s0[r] - mnew); s1[r] = exp2f(s1[r] - mnew); ps += s0[r] + s1[r]; }
                    lrow = lrow * alpha + ps;
#pragma unroll
                    for (int r = 0; r < 16; ++r) { o0[r] *= alpha; o1[r] *= alpha; }
#pragma unroll
                    for (int st = 0; st < 4; ++st) {
                        u32x4 pw;
                        if (st < 2) pw = (u32x4){pk2(s0[8 * st], s0[8 * st + 1]), pk2(s0[8 * st + 2], s0[8 * st + 3]), pk2(s0[8 * st + 4], s0[8 * st + 5]), pk2(s0[8 * st + 6], s0[8 * st + 7])};
                        else pw = (u32x4){pk2(s1[8 * (st - 2)], s1[8 * (st - 2) + 1]), pk2(s1[8 * (st - 2) + 2], s1[8 * (st - 2) + 3]), pk2(s1[8 * (st - 2) + 4], s1[8 * (st - 2) + 5]), pk2(s1[8 * (st - 2) + 6], s1[8 * (st - 2) + 7])};
                        const bf16x8 pf = __builtin_bit_cast(bf16x8, pw);
                        { const LAS bf16_t* vp = Vc + r32 * VSTR + 16 * st + 4 * hi5; const u32x2 v0 = *(const LAS u32x2*)vp, v1 = *(const LAS u32x2*)(vp + 8); const u32x4 vw = (u32x4){v0.x, v0.y, v1.x, v1.y}; o0 = MFMA32(__builtin_bit_cast(bf16x8, vw), pf, o0); }
                        { const LAS bf16_t* vp = Vc + (32 + r32) * VSTR + 16 * st + 4 * hi5; const u32x2 v0 = *(const LAS u32x2*)vp, v1 = *(const LAS u32x2*)(vp + 8); const u32x4 vw = (u32x4){v0.x, v0.y, v1.x, v1.y}; o1 = MFMA32(__builtin_bit_cast(bf16x8, vw), pf, o1); }
                    }
                    if (kt + 1 < NT) { LAS unsigned char* kb_ = lds + (cur ^ 1) * KBUF; LAS unsigned char* vb_ = lds + 2 * KBUF + (cur ^ 1) * VBUF;
                        *(LAS u32x4*)(kb_ + (kkey0 * KSTR + 8 * kch0) * 2) = kr0; if (k1v) *(LAS u32x4*)(kb_ + (kkey1 * KSTR + 8 * kch1) * 2) = kr1;
                        *(LAS u32x2*)(vb_ + (vdv * VSTR + 8 * vch) * 2) = (u32x2){vr.x, vr.y}; *(LAS u32x2*)(vb_ + (vdv * VSTR + 8 * vch + 4) * 2) = (u32x2){vr.z, vr.w}; }
                    __syncthreads();
                }
                lrow += __shfl_xor(lrow, 32);
                const float il = 1.0f / lrow;
                bf16_t* orow = XA + (size_t)trow * D + h * 64;
#pragma unroll
                for (int g4 = 0; g4 < 4; ++g4) { *(u32x2*)(orow + 8 * g4 + 4 * hi5) = (u32x2){pk2(o0[4 * g4] * il, o0[4 * g4 + 1] * il), pk2(o0[4 * g4 + 2] * il, o0[4 * g4 + 3] * il)};
                    *(u32x2*)(orow + 32 + 8 * g4 + 4 * hi5) = (u32x2){pk2(o1[4 * g4] * il, o1[4 * g4 + 1] * il), pk2(o1[4 * g4 + 2] * il, o1[4 * g4 + 3] * il)}; }
            }
        }
        __syncthreads();
        for (int u = blk; u < 256; u += G) mem_attn_unit(u, 1, (const bf16_t*)(ws + WS_PROJ1), D, KVL + QL);
        SEAM(13);
    }
    if (IN(14)) {
        pg8::Gemm g{XA, (const bf16_t*)(ws + WS_WOUT) + (size_t)D * D, D, D, D}; pg8::StaticOrder S; S.init(T, D, G, blk);
        pg8::EpiF32Res E{out, out, D};
        pg8::gemm_phase<pg8::EpiF32Res, pg8::StaticOrder, false>(lds, g, S, E, nullptr);
        SEAM(14);
    }
    if (IN(15)) { route_phase(1, rsbase + 3 * T); SEAM(15); }
    if (IN(16)) { moe_gateup(1, rsbase + 3 * T); SEAM(16); }
    if (IN(17)) { moe_down(1); SEAM(17); }
    if (IN(18)) { combine_phase(1, nullptr); }
#undef IN
#undef SEAM
}

#ifndef MK_FUSED
#define MK_FUSED 1
#endif
#ifndef MK_LAST_PHASE
#define MK_LAST_PHASE NPHASE
#endif
extern "C" void kernel_launch(void* const* d_in, const int* in_sizes, int n_in, void* d_out, int out_size, void* d_ws, size_t ws_size, hipStream_t stream) {
    static int grid = 0;
    if (grid == 0) {
        if (n_in != 27 || out_size != T * D || ws_size < WS_END) { fprintf(stderr, "kernel_launch: unexpected shapes (n_in %d out %d ws %zu)\n", n_in, out_size, ws_size); grid = -1; return; }
        int dev = 0, cus = 0, per_cu = 0;
        if (hipGetDevice(&dev) != hipSuccess || hipDeviceGetAttribute(&cus, hipDeviceAttributeMultiprocessorCount, dev) != hipSuccess) { grid = -1; return; }
        if (hipFuncSetAttribute((const void*)fwd_kernel, hipFuncAttributeMaxDynamicSharedMemorySize, LDS_BYTES) != hipSuccess) { fprintf(stderr, "kernel_launch: hipFuncSetAttribute failed\n"); grid = -1; return; }
        if (hipOccupancyMaxActiveBlocksPerMultiprocessor(&per_cu, (const void*)fwd_kernel, 512, LDS_BYTES) != hipSuccess || per_cu < 1) { fprintf(stderr, "kernel_launch: occupancy query says %d\n", per_cu); (void)hipGetLastError(); per_cu = 1; }
        grid = cus;
    }
    if (grid < 0) return;
    (void)hipMemsetAsync((char*)d_ws + WS_CTL, 0, CTL_ZERO_BYTES, stream);
    Args a{};
    for (int i = 0; i < 27; ++i) a.in[i] = d_in[i];
    a.out = (float*)d_out; a.ws = (unsigned char*)d_ws;
#if MK_FUSED
    a.ph_lo = 0; a.ph_hi = MK_LAST_PHASE;
    hipLaunchKernelGGL(fwd_kernel, dim3(grid), dim3(512), LDS_BYTES, stream, a);
#else
    for (int ph = 0; ph < MK_LAST_PHASE; ++ph) { a.ph_lo = ph; a.ph_hi = ph + 1; hipLaunchKernelGGL(fwd_kernel, dim3(grid), dim3(512), LDS_BYTES, stream, a); }
#endif
}
```

```cpp
#include <hip/hip_runtime.h>
#include <cstdio>
#include <cstdint>

#define GAS __attribute__((address_space(1)))
#define LAS __attribute__((address_space(3)))
typedef unsigned short bf16_t;
typedef short bf16x8 __attribute__((ext_vector_type(8)));
typedef short s16x4 __attribute__((ext_vector_type(4)));
typedef float f32x4 __attribute__((ext_vector_type(4)));
typedef float f32x16 __attribute__((ext_vector_type(16)));
typedef float f32x2 __attribute__((ext_vector_type(2)));
typedef unsigned u32x4 __attribute__((ext_vector_type(4)));
typedef unsigned u32x2 __attribute__((ext_vector_type(2)));

constexpr int D = 1024, NB = 8, SEQ = 4096, T = NB * SEQ;
constexpr int NH = 12, HD = 64, MAINW = 768, MEMW = 256, NMEM = 256;
constexpr int A_IN = 4 * MAINW + MEMW;
constexpr int QL = 384, KVL = 256, QKH = 96, ROPED = 32;
constexpr int NE = 32, DE = 256;
constexpr int RCH = 128, NCH = SEQ / RCH;
constexpr float EPS = 1e-6f;
constexpr int PMAX = 2 * T + NE * 256;
constexpr int LDQ = 1280, LDKV = 1536;

constexpr size_t MiB = 1u << 20;
constexpr size_t WS_CTL = 0, CTL_ZERO_BYTES = 1 * MiB;
constexpr size_t WS_WIN0 = 1 * MiB;
constexpr size_t WS_WOUT = WS_WIN0 + (size_t)A_IN * D * 2;
constexpr size_t WS_WMKV = WS_WOUT + (size_t)2 * D * D * 2;
constexpr size_t WS_WIN1 = WS_WMKV + (size_t)D * D * 2;
constexpr size_t WS_WUKV = WS_WIN1 + (size_t)D * D * 2;
constexpr size_t WS_WUQ = WS_WUKV + (size_t)1536 * 256 * 2;
constexpr size_t WS_WR = WS_WUQ + (size_t)1280 * 384 * 2;
constexpr size_t WS_BR = WS_WR + (size_t)2 * 2 * 36 * 1024 * 2;
constexpr size_t WS_RS0 = WS_BR + 4096;
constexpr size_t WS_TKER = WS_RS0 + (size_t)4 * T * 4;
constexpr size_t WS_TKW = WS_TKER + (size_t)2 * T * 2 * 4;
constexpr size_t WS_SMALL_END = WS_TKW + (size_t)2 * T * 2 * 4;
static_assert(WS_SMALL_END <= 20 * MiB, "small region");
constexpr size_t WS_CS64 = 20 * MiB;
constexpr size_t WS_CS32 = 28 * MiB;
constexpr size_t WS_WEXP = 32 * MiB;
constexpr size_t WEXP_L = 0, WEXP_DN = 32 * MiB;
constexpr size_t WS_VT = 80 * MiB;
constexpr size_t WS_MEMB = 128 * MiB;
constexpr size_t WS_KVM = 132 * MiB;
constexpr size_t WS_LIST = 136 * MiB;
constexpr size_t WS_XA = 144 * MiB;
constexpr size_t WS_BIG = 208 * MiB;
constexpr size_t WS_PROJ0 = WS_BIG;
constexpr size_t WS_UT = WS_BIG + 208 * MiB;
constexpr size_t WS_RT = WS_UT + 48 * MiB;
constexpr size_t WS_HID = WS_BIG;
constexpr size_t WS_YS = WS_BIG + 36 * MiB;
constexpr size_t WS_PROJ1 = WS_BIG;
constexpr size_t WS_KV = WS_BIG + 64 * MiB;
constexpr size_t WS_Q = WS_KV + 96 * MiB;
constexpr size_t WS_XR = WS_BIG + 240 * MiB;
constexpr size_t WS_END = 512 * MiB;
static_assert(WS_RT + 24 * MiB <= WS_END && WS_VT + 48 * MiB <= WS_MEMB && WS_Q + 80 * MiB <= WS_XR && WS_XR + 64 * MiB <= WS_END && WS_YS + (size_t)PMAX * 1024 * 2 <= WS_END && (size_t)PMAX * 256 * 2 <= 36 * MiB, "ws map");
constexpr int CW_CNT = 64;
constexpr int CW_BAR = 4096;

constexpr int LDS_BYTES = 163840;
constexpr int L_MISC = 131072;
constexpr int L_BARW = LDS_BYTES - 16;

#define RLX_AGENT __ATOMIC_RELAXED, __HIP_MEMORY_SCOPE_AGENT
#define LDS_WAIT() asm volatile("s_waitcnt lgkmcnt(0)" ::: "memory")
#define VM_WAIT() asm volatile("s_waitcnt vmcnt(0)" ::: "memory")

__device__ __forceinline__ unsigned pk2(float lo, float hi);
__device__ __forceinline__ unsigned f2bf(float f);
__device__ __forceinline__ unsigned pk2(float lo, float hi) { typedef __bf16 b2_t __attribute__((ext_vector_type(2))); f32x2 v = {lo, hi}; b2_t b = __builtin_convertvector(v, b2_t); return __builtin_bit_cast(unsigned, b); }
__device__ __forceinline__ unsigned f2bf(float f) { return pk2(f, 0.f) & 0xffffu; }
__device__ __forceinline__ float bf2f(unsigned short b) { return __builtin_bit_cast(float, (unsigned)b << 16); }
__device__ __forceinline__ float bflo(unsigned w) { return __builtin_bit_cast(float, w << 16); }
__device__ __forceinline__ float bfhi(unsigned w) { return __builtin_bit_cast(float, w & 0xffff0000u); }
__device__ __forceinline__ float wave_sum(float v) {
#pragma unroll
    for (int o = 1; o < 64; o <<= 1) v += __shfl_xor(v, o);
    return v;
}
__device__ __forceinline__ float siluf(float a) { return a / (1.f + __expf(-a)); }
#define MFMA16(a, b, c) __builtin_amdgcn_mfma_f32_16x16x32_bf16((a), (b), (c), 0, 0, 0)
#define MFMA32(a, b, c) __builtin_amdgcn_mfma_f32_32x32x16_bf16((a), (b), (c), 0, 0, 0)

#define XB_TMO      128
#define XB_XCNT(j)  (256  + 64 * (j))
#define XB_XSUB(j)  (1280 + 64 * (j))
#define XB_XGEN(j)  (2304 + 64 * (j))
#define XB_TOP      3328
#define XB_TOPGEN   3392
#define XCD_BAR_WORDS 3456
#define XB_SPIN_CAP (1u << 18)
__device__ __forceinline__ unsigned xb_ld(unsigned* p)              { return __hip_atomic_load(p, __ATOMIC_RELAXED, __HIP_MEMORY_SCOPE_AGENT); }
__device__ __forceinline__ unsigned xb_add(unsigned* p, unsigned v) { return __hip_atomic_fetch_add(p, v, __ATOMIC_RELAXED, __HIP_MEMORY_SCOPE_AGENT); }
__device__ __forceinline__ unsigned xb_xcc_id() { return (unsigned)__builtin_amdgcn_s_getreg((3 << 11) | 20) & 0xFu; }
#define XB_SPIN(cond, bar) do { unsigned _sp = 0; while (cond) { __builtin_amdgcn_s_sleep(1); \
    if ((++_sp & 255u) == 0u) { if (xb_ld(&(bar)[XB_TMO])) break; if (_sp > XB_SPIN_CAP) { atomicAdd(&(bar)[XB_TMO], 1u); break; } } } } while (0)
struct XcdBarrier { unsigned* bar; unsigned x; volatile LAS unsigned* st; };
__device__ __forceinline__ XcdBarrier xcd_barrier_post(unsigned* bar, volatile LAS unsigned* st) {
    XcdBarrier b; b.bar = bar; b.x = xb_xcc_id(); b.st = st;
    if (threadIdx.x == 0) (void)xb_add(&bar[XB_XCNT(b.x)], 1u);
    return b;
}
__device__ __forceinline__ void xcd_barrier_complete(unsigned* bar, unsigned x, unsigned& nloc, unsigned& nx) {
    const unsigned G = gridDim.x * gridDim.y * gridDim.z;
    unsigned sum, cnt, mine, sp = 0u;
    for (;;) {
        sum = 0u; cnt = 0u; mine = 0u;
#pragma unroll
        for (unsigned j = 0; j < 16; ++j) { const unsigned c = xb_ld(&bar[XB_XCNT(j)]); sum += c; cnt += (c > 0u) ? 1u : 0u; mine = (j == x) ? c : mine; }
        if (sum == G) break;
        __builtin_amdgcn_s_sleep(1);
        if ((++sp & 255u) == 0u) { if (xb_ld(&bar[XB_TMO])) break; if (sp > XB_SPIN_CAP) { atomicAdd(&bar[XB_TMO], 1u); break; } }
    }
    nloc = mine > 0u ? mine : 1u; nx = cnt > 0u ? cnt : 1u;
}
__device__ __forceinline__ void xcd_barrier(const XcdBarrier& b) {
    asm volatile("s_waitcnt vmcnt(0)" ::: "memory");
    __syncthreads();
    if (threadIdx.x == 0) {
        unsigned* bar = b.bar;
        __builtin_amdgcn_s_waitcnt(0);
        unsigned nloc = b.st[0], nx = b.st[1];
        if (nloc == 0u) { xcd_barrier_complete(bar, b.x, nloc, nx); b.st[0] = nloc; b.st[1] = nx; }
        const unsigned old = xb_add(&bar[XB_XSUB(b.x)], 1u);
        const unsigned gen = old / nloc;
        if (old + 1u == (gen + 1u) * nloc) {
            __builtin_amdgcn_fence(__ATOMIC_RELEASE, "agent");
            asm volatile("s_waitcnt vmcnt(0)" ::: "memory");
            const unsigned og = xb_add(&bar[XB_TOP], 1u);
            const unsigned tg = og / nx;
            if (og + 1u == (tg + 1u) * nx) xb_add(&bar[XB_TOPGEN], 1u);
            else XB_SPIN(xb_ld(&bar[XB_TOPGEN]) == tg, bar);
            __builtin_amdgcn_fence(__ATOMIC_ACQUIRE, "agent");
            xb_add(&bar[XB_XGEN(b.x)], 1u);
            asm volatile("s_waitcnt vmcnt(0)" ::: "memory");
        } else {
            XB_SPIN(xb_ld(&bar[XB_XGEN(b.x)]) == gen, bar);
            __builtin_amdgcn_fence(__ATOMIC_ACQUIRE, "agent");
            asm volatile("s_waitcnt vmcnt(0)" ::: "memory");
        }
    }
    __syncthreads();
}

namespace pg8 {
constexpr int BM = 256, BK = 64, HALF = 128, HTB = HALF * BK * 2, STAGE_BYTES = 8 * HTB, NXCD = 8, WGM = 8;
__host__ __device__ __forceinline__ int lds_byte(int r, int c) { const int st = (r >> 4) * 2 + (c >> 5), rr = r & 15, cc = c & 31, ob = rr * 64 + cc * 2; return st * 1024 + (ob ^ (((ob >> 9) & 1) << 5)); }
__host__ __device__ __forceinline__ void stage_rc(int b, int& R, int& C) { const int st = b / 1024, sb = b % 1024, swz = sb ^ (((sb >> 9) & 1) << 5); R = (st >> 1) * 16 + swz / 64; C = (st & 1) * 32 + (swz % 64) / 2; }
__host__ __device__ __forceinline__ int perm32(int rho) { const int n = rho >> 4, i = rho & 15; return 8 * (i >> 2) + 4 * n + (i & 3); }
struct Unit { int pm, pn, ord; };
struct Gemm { const bf16_t* A; const bf16_t* Bt; int lda, ldb, K; };
struct StaticOrder {
    int nM, nN, nwg, G, c;
    __device__ void init(int M, int N, int G_, int c_) { nM = M / BM; nN = N / BM; nwg = nM * nN; G = G_; c = c_; }
    __device__ bool next(int i, Unit& u) const {
        const long L = (long)i * G + c; if (L >= nwg) return false;
        int wgid = (int)L; { const int q = nwg / NXCD, r = nwg % NXCD, xcd = wgid % NXCD, off = wgid / NXCD; wgid = (xcd < r ? xcd * (q + 1) : r * (q + 1) + (xcd - r) * q) + off; }
        const int nig = WGM * nN, gid = wgid / nig, fm = gid * WGM, gsz = (nM - fm) < WGM ? (nM - fm) : WGM;
        u.pm = fm + ((wgid % nig) % gsz); u.pn = (wgid % nig) / gsz; u.ord = i; return true;
    }
};
struct MoeOrder {
    const LAS int* tb; int nNe, G, c;
    __device__ bool next(int i, Unit& u) const {
        const int L = i * G + c; const int NT = tb[32]; if (L >= NT * nNe) return false;
        const int rtg = L / nNe, pn = L % nNe; int e = 0; while (tb[e + 1] <= rtg) ++e;
        u.pm = rtg; u.pn = e * nNe + pn; u.ord = i; return true;
    }
};
__device__ __forceinline__ unsigned cvt_pk_bf16(float lo, float hi) { typedef __bf16 b2 __attribute__((ext_vector_type(2))); f32x2 v = {lo, hi}; b2 b = __builtin_convertvector(v, b2); return __builtin_bit_cast(unsigned, b); }

struct EpiBf16S {
    static constexpr bool PERM = true;
    bf16_t* O; int ldc; const float* rs; int pnmod;
    __device__ __forceinline__ void operator()(const f32x4 (&acc)[2][2][4][2], const Unit& u, int wr, int wc, int fr, int fq) const {
        const int row0 = u.pm * BM + wr * 64 + fr; const int pn = pnmod ? (u.pn % pnmod) : u.pn; const int col0 = pn * BM + wc * 32 + 8 * fq;
#pragma unroll
        for (int ai = 0; ai < 2; ++ai)
#pragma unroll
            for (int m = 0; m < 4; ++m) { const int row = row0 + ai * HALF + m * 16; const float s = rs ? rs[row] : 1.f; bf16_t* rowp = O + (size_t)row * ldc + col0;
#pragma unroll
                for (int bj = 0; bj < 2; ++bj) { const f32x4 v0 = acc[ai][bj][m][0] * s, v1 = acc[ai][bj][m][1] * s;
                    u32x4 w; w.x = cvt_pk_bf16(v0[0], v0[1]); w.y = cvt_pk_bf16(v0[2], v0[3]); w.z = cvt_pk_bf16(v1[0], v1[1]); w.w = cvt_pk_bf16(v1[2], v1[3]);
                    *(u32x4*)(rowp + bj * HALF) = w; } }
    }
};
struct EpiSwiGLU {
    static constexpr bool PERM = true;
    bf16_t* O; const LAS float* rsL;
    __device__ __forceinline__ void operator()(const f32x4 (&acc)[2][2][4][2], const Unit& u, int wr, int wc, int fr, int fq) const {
        const int col0 = (u.pn & 1) * HALF + wc * 32 + 8 * fq;
#pragma unroll
        for (int ai = 0; ai < 2; ++ai)
#pragma unroll
            for (int m = 0; m < 4; ++m) { const int lr = ai * HALF + wr * 64 + m * 16 + fr; const float s = rsL[u.ord * 256 + lr]; bf16_t* rowp = O + (size_t)(u.pm * BM + lr) * 256 + col0;
                float h[8];
#pragma unroll
                for (int n = 0; n < 2; ++n)
#pragma unroll
                    for (int j = 0; j < 4; ++j) { const float g = acc[ai][0][m][n][j] * s, up = acc[ai][1][m][n][j] * s; h[n * 4 + j] = siluf(g) * up; }
                u32x4 w; w.x = cvt_pk_bf16(h[0], h[1]); w.y = cvt_pk_bf16(h[2], h[3]); w.z = cvt_pk_bf16(h[4], h[5]); w.w = cvt_pk_bf16(h[6], h[7]);
                *(u32x4*)rowp = w; }
    }
};
template <bool RBF> struct EpiBf16Res {
    static constexpr bool PERM = true;
    bf16_t* O; const void* R; int ldc;
    __device__ __forceinline__ void operator()(const f32x4 (&acc)[2][2][4][2], const Unit& u, int wr, int wc, int fr, int fq) const {
        const int row0 = u.pm * BM + wr * 64 + fr, col0 = u.pn * BM + wc * 32 + 8 * fq;
#pragma unroll
        for (int ai = 0; ai < 2; ++ai)
#pragma unroll
            for (int m = 0; m < 4; ++m) { const size_t off = (size_t)(row0 + ai * HALF + m * 16) * ldc + col0;
#pragma unroll
                for (int bj = 0; bj < 2; ++bj) { f32x4 v0 = acc[ai][bj][m][0], v1 = acc[ai][bj][m][1];
                    if constexpr (RBF) { const u32x4 r = *(const u32x4*)((const bf16_t*)R + off + bj * HALF);
                        v0[0] += bflo(r.x); v0[1] += bfhi(r.x); v0[2] += bflo(r.y); v0[3] += bfhi(r.y); v1[0] += bflo(r.z); v1[1] += bfhi(r.z); v1[2] += bflo(r.w); v1[3] += bfhi(r.w); }
                    else { const f32x4 r0 = *(const f32x4*)((const float*)R + off + bj * HALF), r1 = *(const f32x4*)((const float*)R + off + bj * HALF + 4); v0 = v0 + r0; v1 = v1 + r1; }
                    u32x4 w; w.x = cvt_pk_bf16(v0[0], v0[1]); w.y = cvt_pk_bf16(v0[2], v0[3]); w.z = cvt_pk_bf16(v1[0], v1[1]); w.w = cvt_pk_bf16(v1[2], v1[3]);
                    *(u32x4*)(O + off + bj * HALF) = w; } }
    }
};
struct EpiF32Res {
    static constexpr bool PERM = false;
    float* C; const float* R; int ldc;
    __device__ __forceinline__ void operator()(const f32x4 (&acc)[2][2][4][2], const Unit& u, int wr, int wc, int fr, int fq) const {
        const int row0 = u.pm * BM + wr * 64 + fr, col0 = u.pn * BM + wc * 32 + 4 * fq;
#pragma unroll
        for (int ai = 0; ai < 2; ++ai)
#pragma unroll
            for (int m = 0; m < 4; ++m) { const size_t off = (size_t)(row0 + ai * HALF + m * 16) * ldc + col0;
#pragma unroll
                for (int bj = 0; bj < 2; ++bj)
#pragma unroll
                    for (int n = 0; n < 2; ++n) { const f32x4 r = *(const f32x4*)(R + off + bj * HALF + n * 16); *(f32x4*)(C + off + bj * HALF + n * 16) = acc[ai][bj][m][n] + r; } }
    }
};

template <class Epi, class Sched, bool GATHER>
__device__ __forceinline__ void gemm_phase(LAS unsigned char* lds, const Gemm g, const Sched& S, const Epi& E, const LAS int* tokL) {
    const int tid = threadIdx.x, wid = __builtin_amdgcn_readfirstlane(tid >> 6), lane = tid & 63, wr = wid >> 2, wc = wid & 3, fr = lane & 15, fq = lane >> 4;
    const int K = g.K, nt = K / BK;
    unsigned voffA[2], voffB[2]; int RA[2], CA[2];
#pragma unroll
    for (int i = 0; i < 2; ++i) { int R, C; stage_rc(tid * 16 + i * 8192, R, C); const int Rb = Epi::PERM ? ((R & ~31) + perm32(R & 31)) : R; RA[i] = R; CA[i] = C;
        voffA[i] = (unsigned)(R * g.lda + C) * 2u; voffB[i] = (unsigned)(Rb * g.ldb + C) * 2u; }
    const size_t kstep = (size_t)(BK * 2);
    const size_t hstepA = GATHER ? 0 : (size_t)HALF * g.lda * 2, hstepB = (size_t)HALF * g.ldb * 2;
    const size_t tstepA = 2 * (size_t)HALF * g.lda * 2, tstepB = 2 * hstepB;
    const unsigned ldsw = (unsigned)wid * 1024u;
    const int aoff = lds_byte(wr * 64 + fr, fq * 8), boff = lds_byte(wc * 32 + fr, fq * 8);
#define PG8_SA(b, h) (((b) * 2 + (h)) * HTB)
#define PG8_SB(b, h) ((4 + (b) * 2 + (h)) * HTB)
#define PG8_STAGE(bufoff, gbase, voff) do { _Pragma("unroll") for (int _i = 0; _i < 2; ++_i) \
        __builtin_amdgcn_global_load_lds((const unsigned*)((const char*)(gbase) + (voff)[_i]), (LAS unsigned*)(lds + (bufoff) + ldsw + _i * 8192), 16, 0, 0); } while (0)
#define PG8_LDA(dst, b, h) do { _Pragma("unroll") for (int m = 0; m < 4; ++m) _Pragma("unroll") for (int k = 0; k < 2; ++k) dst[m][k] = *(const LAS bf16x8*)(lds + PG8_SA(b, h) + aoff + m * 2048 + k * 1024); } while (0)
#define PG8_LDB(dst, b, h) do { _Pragma("unroll") for (int n = 0; n < 2; ++n) _Pragma("unroll") for (int k = 0; k < 2; ++k) dst[n][k] = *(const LAS bf16x8*)(lds + PG8_SB(b, h) + boff + n * 2048 + k * 1024); } while (0)
#define PG8_MMA(ai, bj, At, Bt) do { __builtin_amdgcn_s_setprio(1); _Pragma("unroll") for (int m = 0; m < 4; ++m) _Pragma("unroll") for (int n = 0; n < 2; ++n) _Pragma("unroll") for (int k = 0; k < 2; ++k) \
        acc[ai][bj][m][n] = __builtin_amdgcn_mfma_f32_16x16x32_bf16(Bt[n][k], At[m][k], acc[ai][bj][m][n], 0, 0, 0); __builtin_amdgcn_s_setprio(0); } while (0)
#define PG8_WAIT_V(n) asm volatile("s_waitcnt vmcnt(" #n ")" ::: "memory")
#define PG8_WAIT_L(n) asm volatile("s_waitcnt lgkmcnt(" #n ")" ::: "memory")
#define PG8_BAR __builtin_amdgcn_s_barrier()
#define PG8_SCHED __builtin_amdgcn_sched_barrier(0)
    Unit cur, nxt; int ui = 0;
    if (!S.next(0, cur)) return;
    f32x4 acc[2][2][4][2];
#pragma unroll
    for (int a = 0; a < 2; ++a)
#pragma unroll
        for (int b = 0; b < 2; ++b)
#pragma unroll
            for (int m = 0; m < 4; ++m)
#pragma unroll
                for (int n = 0; n < 2; ++n) acc[a][b][m][n] = (f32x4){0.f, 0.f, 0.f, 0.f};
    bf16x8 At[4][2], B0[2][2], B1[2][2];
    unsigned cv0[2], cv1[2], nv0[2], nv1[2];
    if constexpr (GATHER) {
#pragma unroll
        for (int i = 0; i < 2; ++i) { cv0[i] = (unsigned)(tokL[cur.ord * 256 + RA[i]] * g.lda + CA[i]) * 2u; cv1[i] = (unsigned)(tokL[cur.ord * 256 + HALF + RA[i]] * g.lda + CA[i]) * 2u; nv0[i] = cv0[i]; nv1[i] = cv1[i]; }
    } else {
#pragma unroll
        for (int i = 0; i < 2; ++i) { cv0[i] = voffA[i]; cv1[i] = voffA[i]; nv0[i] = voffA[i]; nv1[i] = voffA[i]; }
    }
    const char* cA = (const char*)g.A + (GATHER ? (size_t)0 : (size_t)cur.pm * tstepA); const char* cB = (const char*)g.Bt + (size_t)cur.pn * tstepB;
    PG8_STAGE(PG8_SB(0, 0), cB, voffB); PG8_STAGE(PG8_SB(0, 1), cB + hstepB, voffB); PG8_STAGE(PG8_SA(0, 0), cA, cv0); PG8_STAGE(PG8_SA(0, 1), cA + hstepA, cv1);
    if (wr == 1) PG8_BAR;
    PG8_WAIT_V(2); PG8_BAR;
    PG8_STAGE(PG8_SB(1, 0), cB + kstep, voffB); PG8_STAGE(PG8_SA(1, 0), cA + kstep, cv0); PG8_STAGE(PG8_SB(1, 1), cB + hstepB + kstep, voffB);
    PG8_WAIT_V(6); PG8_BAR;
    for (;;) {
        const bool has_next = S.next(ui + 1, nxt);
        const char* nA = has_next ? (const char*)g.A + (GATHER ? (size_t)0 : (size_t)nxt.pm * tstepA) : cA; const char* nB = has_next ? (const char*)g.Bt + (size_t)nxt.pn * tstepB : cB;
        if constexpr (GATHER) { if (has_next) {
#pragma unroll
            for (int i = 0; i < 2; ++i) { nv0[i] = (unsigned)(tokL[nxt.ord * 256 + RA[i]] * g.lda + CA[i]) * 2u; nv1[i] = (unsigned)(tokL[nxt.ord * 256 + HALF + RA[i]] * g.lda + CA[i]) * 2u; } } }
#pragma unroll 1
        for (int t = 0; t < nt; t += 2) {
            const bool last = (t == nt - 2);
            const char* a1 = cA + (size_t)(t + 1) * kstep;
            const char* a2 = last ? nA : cA + (size_t)(t + 2) * kstep; const char* b2 = last ? nB : cB + (size_t)(t + 2) * kstep;
            const char* a3 = a2 + kstep; const char* b3 = b2 + kstep;
            unsigned w0[2], w1[2];
#pragma unroll
            for (int i = 0; i < 2; ++i) { w0[i] = last ? nv0[i] : cv0[i]; w1[i] = last ? nv1[i] : cv1[i]; }
            PG8_LDB(B0, 0, 0); PG8_LDB(B1, 0, 1); PG8_SCHED; PG8_LDA(At, 0, 0); PG8_STAGE(PG8_SA(1, 1), a1 + hstepA, cv1);
            PG8_WAIT_V(8); PG8_WAIT_L(0); PG8_BAR; PG8_MMA(0, 0, At, B0); PG8_MMA(0, 1, At, B1); PG8_BAR; PG8_SCHED;
            PG8_LDA(At, 0, 1); PG8_STAGE(PG8_SB(0, 0), b2, voffB); PG8_STAGE(PG8_SB(0, 1), b2 + hstepB, voffB); PG8_STAGE(PG8_SA(0, 0), a2, w0);
            PG8_WAIT_V(8); PG8_WAIT_L(0); PG8_BAR; PG8_MMA(1, 0, At, B0); PG8_MMA(1, 1, At, B1); PG8_BAR; PG8_SCHED;
            PG8_LDB(B0, 1, 0); PG8_LDB(B1, 1, 1); PG8_SCHED; PG8_LDA(At, 1, 0); PG8_STAGE(PG8_SA(0, 1), a2 + hstepA, w1);
            PG8_WAIT_V(8); PG8_WAIT_L(0); PG8_BAR; PG8_MMA(0, 0, At, B0); PG8_MMA(0, 1, At, B1); PG8_BAR; PG8_SCHED;
            PG8_LDA(At, 1, 1); PG8_STAGE(PG8_SB(1, 0), b3, voffB); PG8_STAGE(PG8_SB(1, 1), b3 + hstepB, voffB); PG8_STAGE(PG8_SA(1, 0), a3, w0);
            PG8_WAIT_V(8); PG8_WAIT_L(0); PG8_BAR; PG8_MMA(1, 0, At, B0); PG8_MMA(1, 1, At, B1); PG8_BAR; PG8_SCHED;
        }
        if (wr == 0) PG8_BAR;
        E(acc, cur, wr, wc, fr, fq);
        if (!has_next) break;
#pragma unroll
        for (int a = 0; a < 2; ++a)
#pragma unroll
            for (int b = 0; b < 2; ++b)
#pragma unroll
                for (int m = 0; m < 4; ++m)
#pragma unroll
                    for (int n = 0; n < 2; ++n) acc[a][b][m][n] = (f32x4){0.f, 0.f, 0.f, 0.f};
        cur = nxt; cA = nA; cB = nB; ++ui;
#pragma unroll
        for (int i = 0; i < 2; ++i) { cv0[i] = nv0[i]; cv1[i] = nv1[i]; }
        if (wr == 1) PG8_BAR;
    }
    PG8_WAIT_V(0);
    PG8_BAR;
#undef PG8_SA
#undef PG8_SB
#undef PG8_STAGE
#undef PG8_LDA
#undef PG8_LDB
#undef PG8_MMA
#undef PG8_WAIT_V
#undef PG8_WAIT_L
#undef PG8_BAR
#undef PG8_SCHED
}
}

struct Args { const void* in[27]; float* out; unsigned char* ws; int ph_lo, ph_hi; };
enum { I_X = 0, I_MEM, I_POS, I_LN1, I_LN2, I_WOUT, I_MKV, I_MQN, I_MKN, I_RGW, I_RGB, I_REW, I_REB, I_WG, I_WU, I_WD, I_RWIN, I_RGN, I_KVLN, I_KVWD, I_KVLG, I_KVWU, I_KN, I_MWIN, I_QLG, I_WUQ, I_QN };
constexpr int NPHASE = 19;
constexpr int P0REP_TR = 1, P0REP_TAB = 1, P0REP_X = 1;
__device__ constexpr int REPS[NPHASE] = {1, 1, 1, 1, 1, 1, 1, 1, 1, 1, 1, 1, 1, 1, 1, 1, 1, 1, 1};

__device__ __forceinline__ void tr_item(const float* W, int ldw, int k0, int n0, const float* gain, bf16_t* WT, int ldt, int dst_row, LAS float* scr, int lane) {
    { const int kr = lane >> 3, c4 = lane & 7; f32x4 v[8]; float gv[8];
#pragma unroll
      for (int i = 0; i < 8; ++i) { v[i] = *(const f32x4*)(W + (size_t)(k0 + 8 * i + kr) * ldw + n0 + 4 * c4); gv[i] = gain ? gain[k0 + 8 * i + kr] : 1.f; }
#pragma unroll
      for (int i = 0; i < 8; ++i) { LAS float* d = scr + (8 * i + kr) * 33 + 4 * c4; d[0] = v[i].x * gv[i]; d[1] = v[i].y * gv[i]; d[2] = v[i].z * gv[i]; d[3] = v[i].w * gv[i]; } }
    LDS_WAIT(); asm volatile("" ::: "memory");
    const int c = lane & 7;
#pragma unroll
    for (int j = 0; j < 4; ++j) { const int n = (lane >> 3) + 8 * j; const LAS float* s = scr + (8 * c) * 33 + n;
        u32x4 o; o.x = pk2(s[0 * 33], s[1 * 33]); o.y = pk2(s[2 * 33], s[3 * 33]); o.z = pk2(s[4 * 33], s[5 * 33]); o.w = pk2(s[6 * 33], s[7 * 33]);
        *(u32x4*)(WT + (size_t)(dst_row + n) * ldt + k0 + 8 * c) = o; }
    LDS_WAIT(); asm volatile("" ::: "memory");
}

__device__ __forceinline__ float log_gamma_h(int h) { return log1pf(-exp2f(-5.0f - (float)h)); }

__global__ void __launch_bounds__(512, 2) fwd_kernel(Args args) {
    extern __shared__ __attribute__((aligned(16))) unsigned char lds_raw[];
    LAS unsigned char* lds = (LAS unsigned char*)lds_raw;
    const int tid = threadIdx.x, lane = tid & 63, wave = __builtin_amdgcn_readfirstlane(tid >> 6);
    const int G = gridDim.x, blk = blockIdx.x;
    unsigned char* ws = args.ws;
    unsigned* ctl = (unsigned*)(ws + WS_CTL);
    const int lo = args.ph_lo, hi = args.ph_hi;
    const bool fused = (hi - lo) > 1;
    if (tid < 4) ((volatile LAS unsigned*)(lds + L_BARW))[tid] = 0u;
    __syncthreads();
    XcdBarrier bar; bar.bar = ctl + CW_BAR; bar.x = 0; bar.st = nullptr;
    if (fused) bar = xcd_barrier_post(ctl + CW_BAR, (volatile LAS unsigned*)(lds + L_BARW));
#ifdef ONLY_PHASE
#define IN(k) ((k) == ONLY_PHASE && lo <= (k) && (k) < hi)
#else
#define IN(k) (lo <= (k) && (k) < hi)
#endif
#define SEAM(k) do { if (IN((k) + 1)) xcd_barrier(bar); } while (0)

    const float* x_in = (const float*)args.in[I_X];
    float* out = args.out;
    bf16_t* XA = (bf16_t*)(ws + WS_XA);
    bf16_t* XR = (bf16_t*)(ws + WS_XR);
    const int gw = blk * 8 + wave, NGW = G * 8;
    float* rsbase = (float*)(ws + WS_RS0);
    const int* pos = (const int*)args.in[I_POS];
    const f32x2* cs64 = (const f32x2*)(ws + WS_CS64);
    const f32x2* cs32 = (const f32x2*)(ws + WS_CS32);
    const int gtid = blk * 512 + tid, NGT = G * 512;

    auto convert_experts = [&](int l) {
        LAS float* scr = (LAS float*)(lds + wave * 16384);
        constexpr int I_GU = 64 * 16 * 8, I_DN = 32 * 4 * 32;
        for (int it = gw; it < I_GU + I_DN; it += NGW) {
            int r = it;
            if (r < I_GU) { const int mtx = r / 128, q = r % 128, kb = q / 8, nb = q % 8; const int e = mtx >> 1, which = mtx & 1, le = l * NE + e;
                const float* src = (const float*)args.in[which ? I_WU : I_WG] + (size_t)le * D * DE;
                bf16_t* dst = (bf16_t*)(ws + WS_WEXP) + (size_t)e * 512 * D; const int n0 = 32 * nb;
                tr_item(src, DE, 64 * kb, n0, (const float*)args.in[I_LN2] + l * D, dst, D, (n0 / 128) * 256 + which * 128 + (n0 % 128), scr, lane); continue; } r -= I_GU;
            { const int e = r / 128, q = r % 128, kb = q / 32, nb = q % 32, le = l * NE + e;
              tr_item((const float*)args.in[I_WD] + (size_t)le * DE * D, D, 64 * kb, 32 * nb, nullptr, (bf16_t*)(ws + WS_WEXP + WEXP_DN) + (size_t)e * D * DE, DE, 32 * nb, scr, lane); }
        }
    };

    if (IN(0)) {
        LAS float* scr = (LAS float*)(lds + wave * 16384);
        constexpr int I_A = 16 * 104, I_B = 2 * 16 * 32, I_C = 2 * 16 * 16, I_E = 16 * 9, I_F = 16 * 20, I_G = 4 * 48, I_H = 6 * 36;
        constexpr int NITEMS = I_A + I_B + I_C + I_E + I_F + I_G + I_H;
        for (int rp_ = 0; rp_ < P0REP_TR; ++rp_)
        for (int it = gw; it < NITEMS; it += NGW) {
            int r = it;
            if (r < I_A) { const int kb = r / 104, nb = r % 104; tr_item((const float*)args.in[I_RWIN], A_IN, 64 * kb, 32 * nb, (const float*)args.in[I_LN1], (bf16_t*)(ws + WS_WIN0), D, 32 * nb, scr, lane); continue; } r -= I_A;
            if (r < I_B) { const int l = r / 512, q = r % 512, kb = q / 32, nb = q % 32; tr_item((const float*)args.in[I_WOUT] + (size_t)l * D * D, D, 64 * kb, 32 * nb, nullptr, (bf16_t*)(ws + WS_WOUT) + (size_t)l * D * D, D, 32 * nb, scr, lane); continue; } r -= I_B;
            if (r < I_C) { const int l = r / 256, q = r % 256, kb = q / 16, nb = q % 16; tr_item((const float*)args.in[I_MKV] + (size_t)l * D * 512, 512, 64 * kb, 32 * nb, nullptr, (bf16_t*)(ws + WS_WMKV), D, l * 512 + 32 * nb, scr, lane); continue; } r -= I_C;
            if (r < I_E) { const int kb = r / 9, nb = r % 9; const int n0 = 32 * nb; tr_item((const float*)args.in[I_KVWD], KVL + ROPED, 64 * kb, n0, (const float*)args.in[I_KVLN], (bf16_t*)(ws + WS_WIN1), D, n0 < 256 ? n0 : 896 + (n0 - 256), scr, lane); continue; } r -= I_E;
            if (r < I_F) { const int kb = r / 20, nb = r % 20; const int n0 = 32 * nb; tr_item((const float*)args.in[I_MWIN], QL + MEMW, 64 * kb, n0, (const float*)args.in[I_LN1] + D, (bf16_t*)(ws + WS_WIN1), D, 256 + n0, scr, lane); continue; } r -= I_F;
            if (r < I_G) { const int kb = r / 48, nb = r % 48; tr_item((const float*)args.in[I_KVWU], 1536, 64 * kb, 32 * nb, (const float*)args.in[I_KVLG], (bf16_t*)(ws + WS_WUKV), 256, 32 * nb, scr, lane); continue; } r -= I_G;
            { const int kb = r / 36, nb = r % 36; tr_item((const float*)args.in[I_WUQ], 1152, 64 * kb, 32 * nb, (const float*)args.in[I_QLG], (bf16_t*)(ws + WS_WUQ), 384, 32 * nb, scr, lane); }
        }
        convert_experts(0);
        for (int i = gtid; i < 96 * 1024 / 2; i += NGT) ((unsigned*)(ws + WS_WIN1) + 928 * 1024 / 2)[i] = 0u;
        for (int i = gtid; i < 128 * 384 / 2; i += NGT) ((unsigned*)(ws + WS_WUQ) + 1152 * 384 / 2)[i] = 0u;
        for (int i = gtid; i < 2 * 36 * 1024; i += NGT) { const int l = i / (36 * 1024), q = i % (36 * 1024), n = q / 1024, k = q % 1024;
            const float w = (n < 32 ? ((const float*)args.in[I_REW])[((size_t)l * D + k) * NE + n] : ((const float*)args.in[I_RGW])[((size_t)l * D + k) * 4 + (n - 32)]) * ((const float*)args.in[I_LN2])[l * D + k];
            const unsigned h = f2bf(w); const float rem = w - bf2f((unsigned short)h);
            bf16_t* wr_ = (bf16_t*)(ws + WS_WR) + (size_t)l * 2 * 36 * 1024; wr_[n * 1024 + k] = (bf16_t)h; wr_[36 * 1024 + n * 1024 + k] = (bf16_t)f2bf(rem); }
        for (int i = gtid; i < 2 * 36; i += NGT) { const int l = i / 36, n = i % 36; ((float*)(ws + WS_BR))[l * 64 + n] = n < 32 ? ((const float*)args.in[I_REB])[l * NE + n] : ((const float*)args.in[I_RGB])[l * 4 + n - 32]; }
        for (int rp_ = 0; rp_ < P0REP_TAB; ++rp_) {
        for (int i = gtid; i < T * 32; i += NGT) { const int t = i >> 5, f = i & 31; const float inv = powf(10000.f, -(float)f / 32.f); const float ang = (float)pos[t] * inv; float s, c; sincosf(ang, &s, &c); ((f32x2*)(ws + WS_CS64))[i] = (f32x2){c, s}; }
        for (int i = gtid; i < T * 16; i += NGT) { const int t = i >> 4, f = i & 15; const float inv = powf(10000.f, -(float)f / 16.f); const float ang = (float)pos[t] * inv; float s, c; sincosf(ang, &s, &c); ((f32x2*)(ws + WS_CS32))[i] = (f32x2){c, s}; }
        }
        for (int i = gtid; i < NB * NMEM * D / 4; i += NGT) { const f32x4 v = ((const f32x4*)args.in[I_MEM])[i]; ((u32x2*)(ws + WS_MEMB))[i] = (u32x2){pk2(v.x, v.y), pk2(v.z, v.w)}; }
        for (int rp_ = 0; rp_ < P0REP_X; ++rp_)
        for (int m = gw; m < T; m += NGW) {
            const f32x4* xr = (const f32x4*)(x_in + (size_t)m * D) + lane; f32x4 v[4]; float s = 0.f;
#pragma unroll
            for (int j = 0; j < 4; ++j) { v[j] = xr[64 * j]; s += (v[j].x * v[j].x + v[j].y * v[j].y) + (v[j].z * v[j].z + v[j].w * v[j].w); }
            s = wave_sum(s);
            u32x2* o8 = (u32x2*)(XA + (size_t)m * D) + lane;
#pragma unroll
            for (int j = 0; j < 4; ++j) o8[64 * j] = (u32x2){pk2(v[j].x, v[j].y), pk2(v[j].z, v[j].w)};
            if (lane == 0) rsbase[m] = 1.0f / sqrtf(s * (1.f / D) + EPS);
        }
        SEAM(0);
    }

    if (IN(1)) {
        { pg8::Gemm g{XA, (const bf16_t*)(ws + WS_WIN0), D, D, D}; pg8::StaticOrder S; S.init(T, A_IN, G, blk);
          pg8::EpiBf16S E{(bf16_t*)(ws + WS_PROJ0), A_IN, rsbase, 0};
          pg8::gemm_phase<pg8::EpiBf16S, pg8::StaticOrder, false>(lds, g, S, E, nullptr); }
        { pg8::Gemm g{(const bf16_t*)(ws + WS_MEMB), (const bf16_t*)(ws + WS_WMKV), D, D, D}; pg8::StaticOrder S; S.init(NB * NMEM, D, G, blk);
          pg8::EpiBf16S E{(bf16_t*)(ws + WS_KVM), D, nullptr, 0};
          pg8::gemm_phase<pg8::EpiBf16S, pg8::StaticOrder, false>(lds, g, S, E, nullptr); }
        SEAM(1);
    }

    if (IN(2)) {
        const bf16_t* proj = (const bf16_t*)(ws + WS_PROJ0);
        LAS bf16_t* KT = (LAS bf16_t*)lds; LAS bf16_t* VT = (LAS bf16_t*)(lds + 64 * 136 * 2);
        float* Ut = (float*)(ws + WS_UT);
        const int j = tid >> 2, c = tid & 3;
        for (int u = blk; u < NB * NCH * NH; u += G) {
            const int h = u % NH, bn = u / NH, n = bn % NCH, b = bn / NCH;
            const int t = b * SEQ + n * RCH + j;
            const float lg = log_gamma_h(h);
            const bf16_t* pr = proj + (size_t)t * A_IN;
            const u32x4 ka = *(const u32x4*)(pr + MAINW + h * 64 + 8 * c), kb = *(const u32x4*)(pr + MAINW + h * 64 + 32 + 8 * c);
            const u32x4 va = *(const u32x4*)(pr + 2 * MAINW + h * 64 + 8 * c), vb = *(const u32x4*)(pr + 2 * MAINW + h * 64 + 32 + 8 * c);
            const float sc = 0.125f * __expf(lg * (float)(RCH - 1 - j));
#pragma unroll
            for (int e = 0; e < 8; ++e) { const unsigned wa = ka[e >> 1], wb = kb[e >> 1]; const float x1 = (e & 1) ? bfhi(wa) : bflo(wa), x2 = (e & 1) ? bfhi(wb) : bflo(wb);
                const f32x2 cs = cs64[(size_t)t * 32 + 8 * c + e];
                KT[(8 * c + e) * 136 + j] = (bf16_t)f2bf((x1 * cs.x - x2 * cs.y) * sc); KT[(32 + 8 * c + e) * 136 + j] = (bf16_t)f2bf((x2 * cs.x + x1 * cs.y) * sc);
                const unsigned ua = va[e >> 1], ub = vb[e >> 1];
                VT[(8 * c + e) * 136 + j] = (bf16_t)((e & 1) ? (ua >> 16) : (ua & 0xffffu)); VT[(32 + 8 * c + e) * 136 + j] = (bf16_t)((e & 1) ? (ub >> 16) : (ub & 0xffffu)); }
            __syncthreads();
            const int r16 = lane & 15, q4 = lane >> 4, mt = wave >> 1;
            f32x4 acc2[2] = {(f32x4){0.f, 0.f, 0.f, 0.f}, (f32x4){0.f, 0.f, 0.f, 0.f}};
#pragma unroll
            for (int ks = 0; ks < 4; ++ks) { const bf16x8 a = *(const LAS bf16x8*)(VT + (16 * mt + r16) * 136 + 32 * ks + 8 * q4);
#pragma unroll
                for (int q = 0; q < 2; ++q) { const int nt = 2 * (wave & 1) + q; const bf16x8 bb = *(const LAS bf16x8*)(KT + (16 * nt + r16) * 136 + 32 * ks + 8 * q4); acc2[q] = MFMA16(a, bb, acc2[q]); } }
            float* up = Ut + (size_t)u * 4096;
#pragma unroll
            for (int q = 0; q < 2; ++q) { const int nt = 2 * (wave & 1) + q;
#pragma unroll
                for (int r = 0; r < 4; ++r) up[(16 * mt + 4 * q4 + r) * 64 + 16 * nt + r16] = acc2[q][r]; }
            __syncthreads();
        }
        SEAM(2);
    }

    if (IN(3)) {
        const float* Ut = (const float*)(ws + WS_UT); bf16_t* Rt = (bf16_t*)(ws + WS_RT);
        for (int i = gtid; i < NB * NH * 4096; i += NGT) { const int bh = i >> 12, e = i & 4095, b = bh / NH, h = bh % NH;
            const float dC = __expf(log_gamma_h(h) * (float)RCH); float R = 0.f;
            for (int n = 0; n < NCH; ++n) { const size_t u = (size_t)((b * NCH + n) * NH + h); Rt[u * 4096 + e] = (bf16_t)f2bf(R); R = dC * R + Ut[u * 4096 + e]; } }
        SEAM(3);
    }

    auto mem_attn_unit = [&](int u, int l, const bf16_t* qsrc, int ldq, int qcol) {
        const int qblk = u & 7, head = (u >> 3) & 3, b = u >> 5;
        LAS bf16_t* Kn = (LAS bf16_t*)lds; LAS bf16_t* VTm = (LAS bf16_t*)(lds + 256 * 72 * 2);
        const bf16_t* kvm = (const bf16_t*)(ws + WS_KVM);
        const float* kg = (const float*)args.in[I_MKN] + l * 64; const float* qg = (const float*)args.in[I_MQN] + l * 64;
        { const int key = tid >> 1, half = tid & 1; const bf16_t* kr = kvm + (size_t)(b * NMEM + key) * D + l * 512 + head * 64 + 32 * half;
          u32x4 kk[4], vv[4]; float ss = 0.f;
#pragma unroll
          for (int i = 0; i < 4; ++i) { kk[i] = *(const u32x4*)(kr + 8 * i); vv[i] = *(const u32x4*)(kr + 256 + 8 * i); }
#pragma unroll
          for (int i = 0; i < 4; ++i)
#pragma unroll
              for (int e = 0; e < 4; ++e) { const float a = bflo(kk[i][e]), bq = bfhi(kk[i][e]); ss += a * a + bq * bq; }
          ss += __shfl_xor(ss, 1); const float rstd = 1.0f / sqrtf(ss * (1.f / 64.f) + EPS);
#pragma unroll
          for (int i = 0; i < 4; ++i) { u32x4 o;
#pragma unroll
              for (int e = 0; e < 4; ++e) { const int d = 32 * half + 8 * i + 2 * e; o[e] = pk2(bflo(kk[i][e]) * rstd * kg[d], bfhi(kk[i][e]) * rstd * kg[d + 1]); }
              *(LAS u32x4*)(Kn + key * 72 + 32 * half + 8 * i) = o;
#pragma unroll
              for (int e = 0; e < 4; ++e) { const int d = 32 * half + 8 * i + 2 * e; VTm[d * 264 + key] = (bf16_t)(vv[i][e] & 0xffffu); VTm[(d + 1) * 264 + key] = (bf16_t)(vv[i][e] >> 16); } } }
        __syncthreads();
        const int r16 = lane & 15, q4 = lane >> 4;
        bf16_t* A2 = XA;
        for (int sub = 0; sub < 4; ++sub) {
            const int t = b * SEQ + qblk * 512 + sub * 128 + 16 * wave + r16;
            const bf16_t* qr = qsrc + (size_t)t * ldq + qcol + head * 64;
            const u32x4 q0 = *(const u32x4*)(qr + 8 * q4), q1 = *(const u32x4*)(qr + 32 + 8 * q4);
            float ss = 0.f;
#pragma unroll
            for (int e = 0; e < 4; ++e) { float a = bflo(q0[e]), bq = bfhi(q0[e]); ss += a * a + bq * bq; a = bflo(q1[e]); bq = bfhi(q1[e]); ss += a * a + bq * bq; }
            ss += __shfl_xor(ss, 16); ss += __shfl_xor(ss, 32);
            const float qs = (1.0f / sqrtf(ss * (1.f / 64.f) + EPS)) * (0.125f * 1.4426950408889634f);
            u32x4 qa, qb;
#pragma unroll
            for (int e = 0; e < 4; ++e) { const int d0 = 8 * q4 + 2 * e; qa[e] = pk2(bflo(q0[e]) * qs * qg[d0], bfhi(q0[e]) * qs * qg[d0 + 1]); qb[e] = pk2(bflo(q1[e]) * qs * qg[32 + d0], bfhi(q1[e]) * qs * qg[32 + d0 + 1]); }
            const bf16x8 qf0 = __builtin_bit_cast(bf16x8, qa), qf1 = __builtin_bit_cast(bf16x8, qb);
            f32x4 o[4] = {(f32x4){0.f, 0.f, 0.f, 0.f}, (f32x4){0.f, 0.f, 0.f, 0.f}, (f32x4){0.f, 0.f, 0.f, 0.f}, (f32x4){0.f, 0.f, 0.f, 0.f}};
            float mrow = -INFINITY, ls = 0.f;
#pragma unroll 1
            for (int kc = 0; kc < 4; ++kc) {
                f32x4 st[4]; float mx = -INFINITY;
#pragma unroll
                for (int k4 = 0; k4 < 4; ++k4) { const int kt = 4 * kc + k4; f32x4 a = (f32x4){0.f, 0.f, 0.f, 0.f};
                    a = MFMA16(*(const LAS bf16x8*)(Kn + (16 * kt + r16) * 72 + 8 * q4), qf0, a);
                    a = MFMA16(*(const LAS bf16x8*)(Kn + (16 * kt + r16) * 72 + 32 + 8 * q4), qf1, a);
                    st[k4] = a; mx = fmaxf(mx, fmaxf(fmaxf(a[0], a[1]), fmaxf(a[2], a[3]))); }
                mx = fmaxf(mx, __shfl_xor(mx, 16)); mx = fmaxf(mx, __shfl_xor(mx, 32));
                const float mnew = fmaxf(mrow, mx), alpha = __builtin_amdgcn_exp2f(mrow - mnew); mrow = mnew;
                float ps = 0.f;
#pragma unroll
                for (int k4 = 0; k4 < 4; ++k4)
#pragma unroll
                    for (int r = 0; r < 4; ++r) { st[k4][r] = __builtin_amdgcn_exp2f(st[k4][r] - mnew); ps += st[k4][r]; }
                ls = ls * alpha + ps;
#pragma unroll
                for (int dt = 0; dt < 4; ++dt) o[dt] = o[dt] * alpha;
#pragma unroll
                for (int k2 = 0; k2 < 2; ++k2) { const int kk2 = 2 * kc + k2; u32x4 pw; pw.x = pk2(st[2 * k2][0], st[2 * k2][1]); pw.y = pk2(st[2 * k2][2], st[2 * k2][3]); pw.z = pk2(st[2 * k2 + 1][0], st[2 * k2 + 1][1]); pw.w = pk2(st[2 * k2 + 1][2], st[2 * k2 + 1][3]);
                    const bf16x8 pf = __builtin_bit_cast(bf16x8, pw);
#pragma unroll
                    for (int dt = 0; dt < 4; ++dt) { const LAS bf16_t* vp = VTm + (16 * dt + r16) * 264 + 32 * kk2 + 4 * q4; const u32x2 v0 = *(const LAS u32x2*)vp, v1 = *(const LAS u32x2*)(vp + 16);
                        const u32x4 vw = (u32x4){v0.x, v0.y, v1.x, v1.y}; o[dt] = MFMA16(__builtin_bit_cast(bf16x8, vw), pf, o[dt]); } }
            }
            ls += __shfl_xor(ls, 16); ls += __shfl_xor(ls, 32);
            const float il = 1.0f / ls;
#pragma unroll
            for (int dt = 0; dt < 4; ++dt) { const u32x2 w = (u32x2){pk2(o[dt][0] * il, o[dt][1] * il), pk2(o[dt][2] * il, o[dt][3] * il)}; *(u32x2*)(A2 + (size_t)t * D + MAINW + head * 64 + 16 * dt + 4 * q4) = w; }
        }
        __syncthreads();
    };

    if (IN(4)) {
        const bf16_t* proj = (const bf16_t*)(ws + WS_PROJ0); const bf16_t* Rt = (const bf16_t*)(ws + WS_RT);
        LAS bf16_t* Qs = (LAS bf16_t*)lds; LAS bf16_t* Ks = (LAS bf16_t*)(lds + 128 * 72 * 2); LAS bf16_t* VT = (LAS bf16_t*)(lds + 2 * 128 * 72 * 2); LAS bf16_t* Rs = (LAS bf16_t*)(lds + 2 * 128 * 72 * 2 + 64 * 136 * 2);
        const float* gn = (const float*)args.in[I_RGN];
        const int j = tid >> 2, c = tid & 3;
        for (int u = blk; u < NB * NCH * NH; u += G) {
            const int h = u % NH, bn = u / NH, n = bn % NCH, b = bn / NCH;
            const int t = b * SEQ + n * RCH + j;
            const float lg = log_gamma_h(h), lg2 = lg * 1.4426950408889634f;
            const bf16_t* pr = proj + (size_t)t * A_IN;
            { const u32x4 qa = *(const u32x4*)(pr + h * 64 + 8 * c), qb = *(const u32x4*)(pr + h * 64 + 32 + 8 * c);
              const u32x4 ka = *(const u32x4*)(pr + MAINW + h * 64 + 8 * c), kb = *(const u32x4*)(pr + MAINW + h * 64 + 32 + 8 * c);
              const u32x4 va = *(const u32x4*)(pr + 2 * MAINW + h * 64 + 8 * c), vb = *(const u32x4*)(pr + 2 * MAINW + h * 64 + 32 + 8 * c);
              float q1[8], q2[8], k1[8], k2[8];
#pragma unroll
              for (int e = 0; e < 8; ++e) { const f32x2 cs = cs64[(size_t)t * 32 + 8 * c + e];
                  const float xq1 = (e & 1) ? bfhi(qa[e >> 1]) : bflo(qa[e >> 1]), xq2 = (e & 1) ? bfhi(qb[e >> 1]) : bflo(qb[e >> 1]);
                  const float xk1 = (e & 1) ? bfhi(ka[e >> 1]) : bflo(ka[e >> 1]), xk2 = (e & 1) ? bfhi(kb[e >> 1]) : bflo(kb[e >> 1]);
                  q1[e] = xq1 * cs.x - xq2 * cs.y; q2[e] = xq2 * cs.x + xq1 * cs.y; k1[e] = (xk1 * cs.x - xk2 * cs.y) * 0.125f; k2[e] = (xk2 * cs.x + xk1 * cs.y) * 0.125f;
                  VT[(8 * c + e) * 136 + j] = (bf16_t)((e & 1) ? (va[e >> 1] >> 16) : (va[e >> 1] & 0xffffu)); VT[(32 + 8 * c + e) * 136 + j] = (bf16_t)((e & 1) ? (vb[e >> 1] >> 16) : (vb[e >> 1] & 0xffffu)); }
              *(LAS u32x4*)(Qs + j * 72 + 8 * c) = (u32x4){pk2(q1[0], q1[1]), pk2(q1[2], q1[3]), pk2(q1[4], q1[5]), pk2(q1[6], q1[7])};
              *(LAS u32x4*)(Qs + j * 72 + 32 + 8 * c) = (u32x4){pk2(q2[0], q2[1]), pk2(q2[2], q2[3]), pk2(q2[4], q2[5]), pk2(q2[6], q2[7])};
              *(LAS u32x4*)(Ks + j * 72 + 8 * c) = (u32x4){pk2(k1[0], k1[1]), pk2(k1[2], k1[3]), pk2(k1[4], k1[5]), pk2(k1[6], k1[7])};
              *(LAS u32x4*)(Ks + j * 72 + 32 + 8 * c) = (u32x4){pk2(k2[0], k2[1]), pk2(k2[2], k2[3]), pk2(k2[4], k2[5]), pk2(k2[6], k2[7])};
              *(LAS u32x4*)(Rs + (tid >> 3) * 72 + 8 * (tid & 7)) = *(const u32x4*)(Rt + (size_t)u * 4096 + (tid >> 3) * 64 + 8 * (tid & 7)); }
            __syncthreads();
            const int r16 = lane & 15, q4 = lane >> 4, w = wave, i_loc = 16 * w + r16;
            const bf16x8 qf0 = *(const LAS bf16x8*)(Qs + i_loc * 72 + 8 * q4), qf1 = *(const LAS bf16x8*)(Qs + i_loc * 72 + 32 + 8 * q4);
            f32x4 o[4] = {(f32x4){0.f, 0.f, 0.f, 0.f}, (f32x4){0.f, 0.f, 0.f, 0.f}, (f32x4){0.f, 0.f, 0.f, 0.f}, (f32x4){0.f, 0.f, 0.f, 0.f}};
            for (int kk2 = 0; kk2 <= (w >> 1); ++kk2) {
                f32x4 s0 = (f32x4){0.f, 0.f, 0.f, 0.f}, s1 = (f32x4){0.f, 0.f, 0.f, 0.f};
                s0 = MFMA16(*(const LAS bf16x8*)(Ks + (32 * kk2 + r16) * 72 + 8 * q4), qf0, s0); s0 = MFMA16(*(const LAS bf16x8*)(Ks + (32 * kk2 + r16) * 72 + 32 + 8 * q4), qf1, s0);
                const bool two = (2 * kk2 + 1) <= w;
                if (two) { s1 = MFMA16(*(const LAS bf16x8*)(Ks + (32 * kk2 + 16 + r16) * 72 + 8 * q4), qf0, s1); s1 = MFMA16(*(const LAS bf16x8*)(Ks + (32 * kk2 + 16 + r16) * 72 + 32 + 8 * q4), qf1, s1); }
                float p0[4], p1[4];
#pragma unroll
                for (int r = 0; r < 4; ++r) { const int d0 = i_loc - (32 * kk2 + 4 * q4 + r), d1 = d0 - 16;
                    p0[r] = d0 >= 0 ? s0[r] * __builtin_amdgcn_exp2f(lg2 * (float)d0) : 0.f; p1[r] = (two && d1 >= 0) ? s1[r] * __builtin_amdgcn_exp2f(lg2 * (float)d1) : 0.f; }
                const u32x4 pw = (u32x4){pk2(p0[0], p0[1]), pk2(p0[2], p0[3]), pk2(p1[0], p1[1]), pk2(p1[2], p1[3])}; const bf16x8 pf = __builtin_bit_cast(bf16x8, pw);
#pragma unroll
                for (int dt = 0; dt < 4; ++dt) { const LAS bf16_t* vp = VT + (16 * dt + r16) * 136 + 32 * kk2 + 4 * q4; const u32x2 v0 = *(const LAS u32x2*)vp, v1 = *(const LAS u32x2*)(vp + 16);
                    const u32x4 vw = (u32x4){v0.x, v0.y, v1.x, v1.y}; o[dt] = MFMA16(__builtin_bit_cast(bf16x8, vw), pf, o[dt]); }
            }
            f32x4 xc[4];
#pragma unroll
            for (int dt = 0; dt < 4; ++dt) { f32x4 a = (f32x4){0.f, 0.f, 0.f, 0.f}; a = MFMA16(*(const LAS bf16x8*)(Rs + (16 * dt + r16) * 72 + 8 * q4), qf0, a); a = MFMA16(*(const LAS bf16x8*)(Rs + (16 * dt + r16) * 72 + 32 + 8 * q4), qf1, a); xc[dt] = a; }
            const float gq = exp2f(lg2 * (float)(i_loc + 1));
            float s1 = 0.f;
#pragma unroll
            for (int dt = 0; dt < 4; ++dt)
#pragma unroll
                for (int r = 0; r < 4; ++r) { o[dt][r] += gq * xc[dt][r]; s1 += o[dt][r]; }
            s1 += __shfl_xor(s1, 16); s1 += __shfl_xor(s1, 32);
            const float mean = s1 * (1.f / 64.f); float s2 = 0.f;
#pragma unroll
            for (int dt = 0; dt < 4; ++dt)
#pragma unroll
                for (int r = 0; r < 4; ++r) { o[dt][r] -= mean; s2 += o[dt][r] * o[dt][r]; }
            s2 += __shfl_xor(s2, 16); s2 += __shfl_xor(s2, 32);
            const float rstd = 1.0f / sqrtf(s2 * (1.f / 64.f) + EPS);
            const int tq = b * SEQ + n * RCH + i_loc;
#pragma unroll
            for (int dt = 0; dt < 4; ++dt) { const int dv = 16 * dt + 4 * q4; const u32x2 gg = *(const u32x2*)(proj + (size_t)tq * A_IN + 3 * MAINW + h * 64 + dv); const f32x4 gv = *(const f32x4*)(gn + h * 64 + dv);
                const float y0 = o[dt][0] * rstd * gv[0] * siluf(bflo(gg.x)), y1 = o[dt][1] * rstd * gv[1] * siluf(bfhi(gg.x)), y2 = o[dt][2] * rstd * gv[2] * siluf(bflo(gg.y)), y3 = o[dt][3] * rstd * gv[3] * siluf(bfhi(gg.y));
                *(u32x2*)(XA + (size_t)tq * D + h * 64 + dv) = (u32x2){pk2(y0, y1), pk2(y2, y3)}; }
            __syncthreads();
        }
        for (int u = blk; u < 256; u += G) mem_attn_unit(u, 0, proj, A_IN, 4 * MAINW);
        SEAM(4);
    }

    if (IN(5)) {
        pg8::Gemm g{XA, (const bf16_t*)(ws + WS_WOUT), D, D, D}; pg8::StaticOrder S; S.init(T, D, G, blk);
        pg8::EpiBf16Res<false> E{XR, x_in, D};
        pg8::gemm_phase<pg8::EpiBf16Res<false>, pg8::StaticOrder, false>(lds, g, S, E, nullptr);
        SEAM(5);
    }

    auto route_phase = [&](int l, float* rs) {
        LAS bf16_t* Wh = (LAS bf16_t*)lds; LAS bf16_t* Wl = (LAS bf16_t*)(lds + 36 * 1032 * 2);
        LAS int* lcnt = (LAS int*)(lds + 152000); LAS int* gbase = lcnt + 32; LAS unsigned* rowER = (LAS unsigned*)(lds + 152000 + 256); LAS float* rowW = (LAS float*)(lds + 152000 + 256 + 1024);
        unsigned* cnt = ctl + CW_CNT + 64 * l; int* list = (int*)(ws + WS_LIST);
        unsigned* tker = (unsigned*)(ws + WS_TKER) + (size_t)l * T * 2; float* tkw = (float*)(ws + WS_TKW) + (size_t)l * T * 2;
        const bf16_t* wrg = (const bf16_t*)(ws + WS_WR) + (size_t)l * 2 * 36 * 1024; const float* br = (const float*)(ws + WS_BR) + l * 64;
        for (int chunk = blk; chunk < T / 128; chunk += G) {
            __syncthreads();
            for (int i = tid; i < 2 * 36 * 128; i += 512) { const int hl = i / (36 * 128), q = i % (36 * 128), n = q / 128, c8 = q % 128; *(LAS u32x4*)((hl ? Wl : Wh) + n * 1032 + 8 * c8) = *(const u32x4*)(wrg + (size_t)hl * 36 * 1024 + n * 1024 + 8 * c8); }
            if (tid < 32) lcnt[tid] = 0;
            __syncthreads();
            const int r16 = lane & 15, q4 = lane >> 4; const int rl = 16 * wave + r16, t = chunk * 128 + rl;
            const bf16_t* xr = XR + (size_t)t * D;
            f32x4 acc[3] = {(f32x4){0.f, 0.f, 0.f, 0.f}, (f32x4){0.f, 0.f, 0.f, 0.f}, (f32x4){0.f, 0.f, 0.f, 0.f}}; float ss = 0.f;
#pragma unroll 8
            for (int ks = 0; ks < 32; ++ks) { const u32x4 hw = *(const u32x4*)(xr + 32 * ks + 8 * q4);
#pragma unroll
                for (int e = 0; e < 4; ++e) { const float a = bflo(hw[e]), bq = bfhi(hw[e]); ss += a * a + bq * bq; }
                const bf16x8 xh = __builtin_bit_cast(bf16x8, hw);
#pragma unroll
                for (int nt = 0; nt < 3; ++nt) { const int nrow = (16 * nt + r16) < 36 ? (16 * nt + r16) : 35;
                    const bf16x8 wh = *(const LAS bf16x8*)(Wh + nrow * 1032 + 32 * ks + 8 * q4), wl = *(const LAS bf16x8*)(Wl + nrow * 1032 + 32 * ks + 8 * q4);
                    acc[nt] = MFMA16(wh, xh, acc[nt]); acc[nt] = MFMA16(wl, xh, acc[nt]); } }
            ss += __shfl_xor(ss, 16); ss += __shfl_xor(ss, 32);
            const float rstd = 1.0f / sqrtf(ss * (1.f / D) + EPS);
            if (q4 == 0) rs[t] = rstd;
            __syncthreads();
            LAS float* lg = (LAS float*)lds;
#pragma unroll
            for (int nt = 0; nt < 3; ++nt)
#pragma unroll
                for (int r = 0; r < 4; ++r) { const int n = 16 * nt + 4 * q4 + r; if (n < 36) lg[rl * 40 + n] = acc[nt][r] * rstd + br[n]; }
            LDS_WAIT(); asm volatile("" ::: "memory");
            if (q4 == 0) {
                const LAS float* L = lg + rl * 40;
                int grp = 0; float gm = L[32];
#pragma unroll
                for (int gi = 1; gi < 4; ++gi) if (L[32 + gi] > gm) { gm = L[32 + gi]; grp = gi; }
                float gs = 0.f;
#pragma unroll
                for (int gi = 0; gi < 4; ++gi) gs += __expf(L[32 + gi] - gm);
                const float pg = 1.0f / gs;
                int i0 = 0; float m0 = L[8 * grp];
#pragma unroll
                for (int ji = 1; ji < 8; ++ji) { const float v = L[8 * grp + ji]; if (v > m0) { m0 = v; i0 = ji; } }
                int i1 = -1; float m1 = -INFINITY;
#pragma unroll
                for (int ji = 0; ji < 8; ++ji) { const float v = L[8 * grp + ji]; if (ji != i0 && v > m1) { m1 = v; i1 = ji; } }
                const float e1 = __expf(m1 - m0); const float w0 = pg / (1.f + e1), w1 = pg * e1 / (1.f + e1);
                const int ex0 = grp * 8 + i0, ex1 = grp * 8 + i1;
                const int lr0 = atomicAdd((int*)(lcnt + ex0), 1), lr1 = atomicAdd((int*)(lcnt + ex1), 1);
                rowER[rl * 2] = ((unsigned)ex0 << 16) | (unsigned)lr0; rowER[rl * 2 + 1] = ((unsigned)ex1 << 16) | (unsigned)lr1; rowW[rl * 2] = w0; rowW[rl * 2 + 1] = w1;
            }
            __syncthreads();
            if (tid < 32) gbase[tid] = (int)__hip_atomic_fetch_add(cnt + tid, (unsigned)lcnt[tid], RLX_AGENT);
            __syncthreads();
            if (tid < 256) { const int row = tid >> 1, k = tid & 1; const unsigned er = rowER[row * 2 + k]; const int e = er >> 16, rank = gbase[e] + (int)(er & 0xffffu); const int tt = chunk * 128 + row;
                list[(size_t)e * T + rank] = tt; tker[(size_t)tt * 2 + k] = ((unsigned)e << 16) | (unsigned)rank; tkw[(size_t)tt * 2 + k] = rowW[row * 2 + k]; }
        }
    };
    auto build_tb = [&](int l) {
        LAS int* tb = (LAS int*)(lds + L_MISC); LAS int* cntL = (LAS int*)(lds + L_MISC + 256);
        __syncthreads();
        if (tid == 0) { int a = 0; for (int e = 0; e < NE; ++e) { const int c = (int)__hip_atomic_load(ctl + CW_CNT + 64 * l + e, RLX_AGENT); cntL[e] = c; tb[e] = a; a += (c + 255) >> 8; } tb[32] = a; }
        __syncthreads();
    };
    auto moe_gateup = [&](int l, const float* rs) {
        build_tb(l);
        LAS int* tb = (LAS int*)(lds + L_MISC); LAS int* cntL = (LAS int*)(lds + L_MISC + 256); LAS int* tokL = (LAS int*)(lds + L_MISC + 1024); LAS float* rsL = (LAS float*)(lds + L_MISC + 4096);
        const int* list = (const int*)(ws + WS_LIST);
        pg8::MoeOrder S{tb, 2, G, blk};
        { pg8::Unit u; for (int i = 0; i < 3 && S.next(i, u); ++i) { const int e = u.pn >> 1; if (tid < 256) { int rank = (u.pm - tb[e]) * 256 + tid; if (rank >= cntL[e]) rank = 0; const int tk = list[(size_t)e * T + rank]; tokL[i * 256 + tid] = tk; rsL[i * 256 + tid] = rs[tk]; } } }
        __syncthreads();
        pg8::Gemm g{XR, (const bf16_t*)(ws + WS_WEXP), D, D, D};
        pg8::EpiSwiGLU E{(bf16_t*)(ws + WS_HID), rsL};
        pg8::gemm_phase<pg8::EpiSwiGLU, pg8::MoeOrder, true>(lds, g, S, E, tokL);
    };
    auto moe_down = [&](int l) {
        build_tb(l);
        LAS int* tb = (LAS int*)(lds + L_MISC);
        pg8::MoeOrder S{tb, 4, G, blk};
        pg8::Gemm g{(const bf16_t*)(ws + WS_HID), (const bf16_t*)(ws + WS_WEXP + WEXP_DN), DE, DE, DE};
        pg8::EpiBf16S E{(bf16_t*)(ws + WS_YS), D, nullptr, 4};
        pg8::gemm_phase<pg8::EpiBf16S, pg8::MoeOrder, false>(lds, g, S, E, nullptr);
    };
    auto combine_phase = [&](int l, float* rs) {
        build_tb(l);
        LAS int* tb = (LAS int*)(lds + L_MISC);
        const unsigned* tker = (const unsigned*)(ws + WS_TKER) + (size_t)l * T * 2; const float* tkw = (const float*)(ws + WS_TKW) + (size_t)l * T * 2; const bf16_t* ys = (const bf16_t*)(ws + WS_YS);
        for (int mm = gw; mm < T; mm += 2 * NGW) {
            int mr[2]; mr[0] = mm; mr[1] = (mm + NGW < T) ? mm + NGW : mm; const int nr = (mm + NGW < T) ? 2 : 1;
            u32x4 xv[2][2], ya[2][2], yb[2][2]; float w0[2], w1[2];
#pragma unroll
            for (int q = 0; q < 2; ++q) { const int m = mr[q];
                const unsigned er0 = tker[(size_t)m * 2], er1 = tker[(size_t)m * 2 + 1]; w0[q] = tkw[(size_t)m * 2]; w1[q] = tkw[(size_t)m * 2 + 1];
                const size_t s0 = (size_t)tb[er0 >> 16] * 256 + (er0 & 0xffffu), s1 = (size_t)tb[er1 >> 16] * 256 + (er1 & 0xffffu);
                const u32x4* xr = (const u32x4*)(XR + (size_t)m * D) + lane; const u32x4* y0 = (const u32x4*)(ys + s0 * D) + lane; const u32x4* y1 = (const u32x4*)(ys + s1 * D) + lane;
#pragma unroll
                for (int j = 0; j < 2; ++j) { xv[q][j] = xr[64 * j]; ya[q][j] = y0[64 * j]; yb[q][j] = y1[64 * j]; } }
#pragma unroll
            for (int q = 0; q < 2; ++q) { if (q < nr) { const int m = mr[q]; float s = 0.f;
#pragma unroll
                for (int j = 0; j < 2; ++j) { float v[8];
#pragma unroll
                    for (int e = 0; e < 4; ++e) { v[2 * e] = bflo(xv[q][j][e]) + w0[q] * bflo(ya[q][j][e]) + w1[q] * bflo(yb[q][j][e]); v[2 * e + 1] = bfhi(xv[q][j][e]) + w0[q] * bfhi(ya[q][j][e]) + w1[q] * bfhi(yb[q][j][e]); }
                    if (rs) { u32x4 o;
#pragma unroll
                        for (int e = 0; e < 4; ++e) { o[e] = pk2(v[2 * e], v[2 * e + 1]); const float a = bflo(o[e]), bq = bfhi(o[e]); s += a * a + bq * bq; }
                        ((u32x4*)(XR + (size_t)m * D) + lane)[64 * j] = o; }
                    else { f32x4* op = (f32x4*)(out + (size_t)m * D + 512 * j + 8 * lane); op[0] = (f32x4){v[0], v[1], v[2], v[3]}; op[1] = (f32x4){v[4], v[5], v[6], v[7]}; } }
                if (rs) { s = wave_sum(s); if (lane == 0) rs[m] = 1.0f / sqrtf(s * (1.f / D) + EPS); } } }
        }
    };

    if (IN(6)) { route_phase(0, rsbase + T); SEAM(6); }
    if (IN(7)) { moe_gateup(0, rsbase + T); SEAM(7); }
    if (IN(8)) { moe_down(0); SEAM(8); }
    if (IN(9)) { combine_phase(0, rsbase + 2 * T); convert_experts(1); SEAM(9); }

    if (IN(10)) {
        pg8::Gemm g{XR, (const bf16_t*)(ws + WS_WIN1), D, D, D}; pg8::StaticOrder S; S.init(T, D, G, blk);
        pg8::EpiBf16S E{(bf16_t*)(ws + WS_PROJ1), D, rsbase + 2 * T, 0};
        pg8::gemm_phase<pg8::EpiBf16S, pg8::StaticOrder, false>(lds, g, S, E, nullptr);
        SEAM(10);
    }
    if (IN(11)) {
        { pg8::Gemm g{(const bf16_t*)(ws + WS_PROJ1), (const bf16_t*)(ws + WS_WUKV), D, KVL, KVL}; pg8::StaticOrder S; S.init(T, LDKV, G, blk);
          pg8::EpiBf16S E{(bf16_t*)(ws + WS_KV), LDKV, nullptr, 0};
          pg8::gemm_phase<pg8::EpiBf16S, pg8::StaticOrder, false>(lds, g, S, E, nullptr); }
        { pg8::Gemm g{(const bf16_t*)(ws + WS_PROJ1) + KVL, (const bf16_t*)(ws + WS_WUQ), D, QL, QL}; pg8::StaticOrder S; S.init(T, LDQ, G, blk);
          pg8::EpiBf16S E{(bf16_t*)(ws + WS_Q), LDQ, nullptr, 0};
          pg8::gemm_phase<pg8::EpiBf16S, pg8::StaticOrder, false>(lds, g, S, E, nullptr); }
        SEAM(11);
    }
    if (IN(12)) {
        const bf16_t* proj1 = (const bf16_t*)(ws + WS_PROJ1); bf16_t* KV = (bf16_t*)(ws + WS_KV); bf16_t* Qb = (bf16_t*)(ws + WS_Q); bf16_t* Vt = (bf16_t*)(ws + WS_VT);
        const float* kg = (const float*)args.in[I_KN]; const float* qg = (const float*)args.in[I_QN];
        LAS bf16_t* Vtile = (LAS bf16_t*)lds;
        const float QSC = 0.10206207261596575f * 1.4426950408889634f;
        for (int tl = blk; tl < T / 64; tl += G) {
            const int hh = lane >> 2, s = lane & 3; const bool act = lane < 48;
            for (int rr = 0; rr < 8; ++rr) {
                const int tloc = 8 * wave + rr, t = tl * 64 + tloc; const bf16_t* p1 = proj1 + (size_t)t * D;
                const u32x2 cw = *(const u32x2*)(p1 + 4 * lane); float skv = bflo(cw.x) * bflo(cw.x) + bfhi(cw.x) * bfhi(cw.x) + bflo(cw.y) * bflo(cw.y) + bfhi(cw.y) * bfhi(cw.y);
                float sq = 0.f; if (act) { const u32x4 qw = *(const u32x4*)(p1 + KVL + 8 * lane);
#pragma unroll
                    for (int e = 0; e < 4; ++e) sq += bflo(qw[e]) * bflo(qw[e]) + bfhi(qw[e]) * bfhi(qw[e]); }
                skv = wave_sum(skv); sq = wave_sum(sq);
                const float rkv = 1.0f / sqrtf(skv * (1.f / KVL) + EPS), rq = 1.0f / sqrtf(sq * (1.f / QL) + EPS);
                if (act) {
                    bf16_t* kvr = KV + (size_t)t * LDKV + hh * 128;
                    const u32x4 kn0 = *(const u32x4*)(kvr + 16 * s), kn1 = *(const u32x4*)(kvr + 16 * s + 8), vv0 = *(const u32x4*)(kvr + 64 + 16 * s), vv1 = *(const u32x4*)(kvr + 64 + 16 * s + 8);
                    const u32x2 ra = *(const u32x2*)(p1 + 896 + 4 * s), rb = *(const u32x2*)(p1 + 912 + 4 * s);
                    float kn[16], ar[4], br2[4]; float ssk = 0.f;
#pragma unroll
                    for (int e = 0; e < 4; ++e) { kn[2 * e] = bflo(kn0[e]) * rkv; kn[2 * e + 1] = bfhi(kn0[e]) * rkv; kn[8 + 2 * e] = bflo(kn1[e]) * rkv; kn[8 + 2 * e + 1] = bfhi(kn1[e]) * rkv; }
                    ar[0] = bflo(ra.x); ar[1] = bfhi(ra.x); ar[2] = bflo(ra.y); ar[3] = bfhi(ra.y); br2[0] = bflo(rb.x); br2[1] = bfhi(rb.x); br2[2] = bflo(rb.y); br2[3] = bfhi(rb.y);
#pragma unroll
                    for (int e = 0; e < 16; ++e) ssk += kn[e] * kn[e];
#pragma unroll
                    for (int e = 0; e < 4; ++e) ssk += ar[e] * ar[e] + br2[e] * br2[e];
                    ssk += __shfl_xor(ssk, 1); ssk += __shfl_xor(ssk, 2);
                    const float rk = 1.0f / sqrtf(ssk * (1.f / QKH) + EPS);
                    u32x4 o0, o1;
#pragma unroll
                    for (int e = 0; e < 4; ++e) { o0[e] = pk2(kn[2 * e] * rk * kg[16 * s + 2 * e], kn[2 * e + 1] * rk * kg[16 * s + 2 * e + 1]); o1[e] = pk2(kn[8 + 2 * e] * rk * kg[16 * s + 8 + 2 * e], kn[8 + 2 * e + 1] * rk * kg[16 * s + 8 + 2 * e + 1]); }
                    float r1[4], r2[4];
#pragma unroll
                    for (int e = 0; e < 4; ++e) { const int i = 4 * s + e; const f32x2 cs = cs32[(size_t)t * 16 + i]; const float a = ar[e] * rk * kg[64 + i], bq = br2[e] * rk * kg[80 + i]; r1[e] = a * cs.x - bq * cs.y; r2[e] = bq * cs.x + a * cs.y; }
#pragma unroll
                    for (int e = 0; e < 4; ++e) { Vtile[(hh * 64 + 16 * s + 2 * e) * 72 + tloc] = (bf16_t)f2bf(bflo(vv0[e]) * rkv); Vtile[(hh * 64 + 16 * s + 2 * e + 1) * 72 + tloc] = (bf16_t)f2bf(bfhi(vv0[e]) * rkv);
                        Vtile[(hh * 64 + 16 * s + 8 + 2 * e) * 72 + tloc] = (bf16_t)f2bf(bflo(vv1[e]) * rkv); Vtile[(hh * 64 + 16 * s + 8 + 2 * e + 1) * 72 + tloc] = (bf16_t)f2bf(bfhi(vv1[e]) * rkv); }
                    *(u32x4*)(kvr + 16 * s) = o0; *(u32x4*)(kvr + 16 * s + 8) = o1;
                    *(u32x2*)(kvr + 64 + 4 * s) = (u32x2){pk2(r1[0], r1[1]), pk2(r1[2], r1[3])}; *(u32x2*)(kvr + 80 + 4 * s) = (u32x2){pk2(r2[0], r2[1]), pk2(r2[2], r2[3])};
                    bf16_t* qr = Qb + (size_t)t * LDQ + hh * QKH;
                    const u32x4 qn0 = *(const u32x4*)(qr + 16 * s), qn1 = *(const u32x4*)(qr + 16 * s + 8); const u32x2 qa = *(const u32x2*)(qr + 64 + 4 * s), qb = *(const u32x2*)(qr + 80 + 4 * s);
                    float qn[16], qa4[4], qb4[4]; float ssq = 0.f;
#pragma unroll
                    for (int e = 0; e < 4; ++e) { qn[2 * e] = bflo(qn0[e]) * rq; qn[2 * e + 1] = bfhi(qn0[e]) * rq; qn[8 + 2 * e] = bflo(qn1[e]) * rq; qn[8 + 2 * e + 1] = bfhi(qn1[e]) * rq; }
                    qa4[0] = bflo(qa.x) * rq; qa4[1] = bfhi(qa.x) * rq; qa4[2] = bflo(qa.y) * rq; qa4[3] = bfhi(qa.y) * rq; qb4[0] = bflo(qb.x) * rq; qb4[1] = bfhi(qb.x) * rq; qb4[2] = bflo(qb.y) * rq; qb4[3] = bfhi(qb.y) * rq;
#pragma unroll
                    for (int e = 0; e < 16; ++e) ssq += qn[e] * qn[e];
#pragma unroll
                    for (int e = 0; e < 4; ++e) ssq += qa4[e] * qa4[e] + qb4[e] * qb4[e];
                    ssq += __shfl_xor(ssq, 1); ssq += __shfl_xor(ssq, 2);
                    const float rqh = (1.0f / sqrtf(ssq * (1.f / QKH) + EPS)) * QSC;
                    u32x4 p0, p1v;
#pragma unroll
                    for (int e = 0; e < 4; ++e) { p0[e] = pk2(qn[2 * e] * rqh * qg[16 * s + 2 * e], qn[2 * e + 1] * rqh * qg[16 * s + 2 * e + 1]); p1v[e] = pk2(qn[8 + 2 * e] * rqh * qg[16 * s + 8 + 2 * e], qn[8 + 2 * e + 1] * rqh * qg[16 * s + 8 + 2 * e + 1]); }
                    float t1[4], t2[4];
#pragma unroll
                    for (int e = 0; e < 4; ++e) { const int i = 4 * s + e; const f32x2 cs = cs32[(size_t)t * 16 + i]; const float a = qa4[e] * rqh * qg[64 + i], bq = qb4[e] * rqh * qg[80 + i]; t1[e] = a * cs.x - bq * cs.y; t2[e] = bq * cs.x + a * cs.y; }
                    *(u32x4*)(qr + 16 * s) = p0; *(u32x4*)(qr + 16 * s + 8) = p1v;
                    *(u32x2*)(qr + 64 + 4 * s) = (u32x2){pk2(t1[0], t1[1]), pk2(t1[2], t1[3])}; *(u32x2*)(qr + 80 + 4 * s) = (u32x2){pk2(t2[0], t2[1]), pk2(t2[2], t2[3])};
                }
            }
            __syncthreads();
            { const int b = (tl * 64) / SEQ, s0 = (tl * 64) % SEQ;
              for (int i = tid; i < 768 * 8; i += 512) { const int row = i >> 3, ch = i & 7; *(u32x4*)(Vt + ((size_t)(b * NH * 64 + row)) * SEQ + s0 + 8 * ch) = *(const LAS u32x4*)(Vtile + row * 72 + 8 * ch); } }
            __syncthreads();
        }
        SEAM(12);
    }

    if (IN(13)) {
        const bf16_t* Qb = (const bf16_t*)(ws + WS_Q); const bf16_t* KV = (const bf16_t*)(ws + WS_KV); const bf16_t* Vt = (const bf16_t*)(ws + WS_VT);
        constexpr int KSTR = 104, VSTR = 68, KBUF = 64 * KSTR * 2, VBUF = 64 * VSTR * 2;
        const int r32 = lane & 31, hi5 = lane >> 5;
        for (int pi = 0; pi < 3; ++pi) {
            const int p = blk + G * pi; if (p >= 768) break;
            const int bh = p >> 3, sidx = p & 7, b = bh / NH, h = bh % NH;
            for (int which = 0; which < 2; ++which) {
                const int qb = which ? sidx : 15 - sidx;
                const int NT = 4 * (qb + 1);
                const int trow = b * SEQ + qb * 256 + 32 * wave + r32;
                bf16x8 qf[6];
#pragma unroll
                for (int d0 = 0; d0 < 6; ++d0) qf[d0] = *(const bf16x8*)(Qb + (size_t)trow * LDQ + h * QKH + 16 * d0 + 8 * hi5);
                const int kc0 = tid, kc1 = 512 + tid; const bool k1v = kc1 < 768;
                const int kkey0 = kc0 / 12, kch0 = kc0 % 12, kkey1 = k1v ? kc1 / 12 : 0, kch1 = k1v ? kc1 % 12 : 0;
                const int vdv = tid >> 3, vch = tid & 7;
                const bf16_t* kbase = KV + (size_t)(b * SEQ) * LDKV + h * 128; const bf16_t* vbase = Vt + (size_t)(bh * 64 + vdv) * SEQ + 8 * vch;
                u32x4 kr0, kr1, vr;
                kr0 = *(const u32x4*)(kbase + (size_t)kkey0 * LDKV + 8 * kch0); kr1 = *(const u32x4*)(kbase + (size_t)kkey1 * LDKV + 8 * kch1); vr = *(const u32x4*)vbase;
                __syncthreads();
                { LAS unsigned char* kb_ = lds; LAS unsigned char* vb_ = lds + 2 * KBUF;
                  *(LAS u32x4*)(kb_ + (kkey0 * KSTR + 8 * kch0) * 2) = kr0; if (k1v) *(LAS u32x4*)(kb_ + (kkey1 * KSTR + 8 * kch1) * 2) = kr1;
                  *(LAS u32x2*)(vb_ + (vdv * VSTR + 8 * vch) * 2) = (u32x2){vr.x, vr.y}; *(LAS u32x2*)(vb_ + (vdv * VSTR + 8 * vch + 4) * 2) = (u32x2){vr.z, vr.w}; }
                __syncthreads();
                f32x16 o0, o1, negm;
#pragma unroll
                for (int r = 0; r < 16; ++r) { o0[r] = 0.f; o1[r] = 0.f; negm[r] = 0.f; }
                float mref = 0.f, lrow = 0.f;
                for (int kt = 0; kt < NT; ++kt) {
                    const int cur = kt & 1;
                    if (kt + 1 < NT) { const size_t ko = (size_t)(64 * (kt + 1)) * LDKV; kr0 = *(const u32x4*)(kbase + ko + (size_t)kkey0 * LDKV + 8 * kch0); kr1 = *(const u32x4*)(kbase + ko + (size_t)kkey1 * LDKV + 8 * kch1); vr = *(const u32x4*)(vbase + 64 * (kt + 1)); }
                    const LAS bf16_t* Kc = (const LAS bf16_t*)(lds + cur * KBUF); const LAS bf16_t* Vc = (const LAS bf16_t*)(lds + 2 * KBUF + cur * VBUF);
                    f32x16 s0, s1;
                    s0 = MFMA32(*(const LAS bf16x8*)(Kc + r32 * KSTR + 8 * hi5), qf[0], negm); s1 = MFMA32(*(const LAS bf16x8*)(Kc + (32 + r32) * KSTR + 8 * hi5), qf[0], negm);
#pragma unroll
                    for (int d0 = 1; d0 < 6; ++d0) { s0 = MFMA32(*(const LAS bf16x8*)(Kc + r32 * KSTR + 16 * d0 + 8 * hi5), qf[d0], s0); s1 = MFMA32(*(const LAS bf16x8*)(Kc + (32 + r32) * KSTR + 16 * d0 + 8 * hi5), qf[d0], s1); }
                    if (kt >= NT - 4) { const int qrel = qb * 256 + 32 * wave + r32 - 64 * kt;
#pragma unroll
                        for (int r = 0; r < 16; ++r) { const int kv = (r & 3) + 8 * (r >> 2) + 4 * hi5; if (kv > qrel) s0[r] = -INFINITY; if (kv + 32 > qrel) s1[r] = -INFINITY; } }
                    float mx = fmaxf(s0[0], s1[0]);
#pragma unroll
                    for (int r = 1; r < 16; ++r) mx = fmaxf(mx, fmaxf(s0[r], s1[r]));
                    mx = fmaxf(mx, __shfl_xor(mx, 32));
                    if (kt == 0 || __any(mx > 8.0f)) {
                        const float dl = (kt == 0) ? mx : fmaxf(mx, 0.f); mref += dl;
#pragma unroll
                        for (int r = 0; r < 16; ++r) { s0[r] -= dl; s1[r] -= dl; negm[r] = -mref; }
                        const float f = __builtin_amdgcn_exp2f(-dl); lrow *= f;
#pragma unroll
                        for (int r = 0; r < 16; ++r) { o0[r] *= f; o1[r] *= f; }
                    }
                    float ps = 0.f;
#pragma unroll
                    for (int r = 0; r < 16; ++r) { s0[r] = __builtin_amdgcn_exp2f(s0[r]); s1[r] = __builtin_amdgcn_exp2f(s1[r]); ps += s0[r] + s1[r]; }
                    lrow += ps;
#pragma unroll
                    for (int st = 0; st < 4; ++st) {
                        u32x4 pw;
                        if (st < 2) pw = (u32x4){pk2(s0[8 * st], s0[8 * st + 1]), pk2(s0[8 * st + 2], s0[8 * st + 3]), pk2(s0[8 * st + 4], s0[8 * st + 5]), pk2(s0[8 * st + 6], s0[8 * st + 7])};
                        else pw = (u32x4){pk2(s1[8 * (st - 2)], s1[8 * (st - 2) + 1]), pk2(s1[8 * (st - 2) + 2], s1[8 * (st - 2) + 3]), pk2(s1[8 * (st - 2) + 4], s1[8 * (st - 2) + 5]), pk2(s1[8 * (st - 2) + 6], s1[8 * (st - 2) + 7])};
                        const bf16x8 pf = __builtin_bit_cast(bf16x8, pw);
                        { const LAS bf16_t* vp = Vc + r32 * VSTR + 16 * st + 4 * hi5; const u32x2 v0 = *(const LAS u32x2*)vp, v1 = *(const LAS u32x2*)(vp + 8); const u32x4 vw = (u32x4){v0.x, v0.y, v1.x, v1.y}; o0 = MFMA32(__builtin_bit_cast(bf16x8, vw), pf, o0); }
                        { const LAS bf16_t* vp = Vc + (32 + r32) * VSTR + 16 * st + 4 * hi5; const u32x2 v0 = *(const LAS u32x2*)vp, v1 = *(const LAS u32x2*)(vp + 8); const u32x4 vw = (u32x4){v0.x, v0.y, v1.x, v1.y}; o1 = MFMA32(__builtin_bit_cast(bf16x8, vw), pf, o1); }
                    }
                    if (kt + 1 < NT) { LAS unsigned char* kb_ = lds + (cur ^ 1) * KBUF; LAS unsigned char* vb_ = lds + 2 * KBUF + (cur ^ 1) * VBUF;
                        *(LAS u32x4*)(kb_ + (kkey0 * KSTR + 8 * kch0) * 2) = kr0; if (k1v) *(LAS u32x4*)(kb_ + (kkey1 * KSTR + 8 * kch1) * 2) = kr1;
                        *(LAS u32x2*)(vb_ + (vdv * VSTR + 8 * vch) * 2) = (u32x2){vr.x, vr.y}; *(LAS u32x2*)(vb_ + (vdv * VSTR + 8 * vch + 4) * 2) = (u32x2){vr.z, vr.w}; }
                    __syncthreads();
                }
                lrow += __shfl_xor(lrow, 32);
                const float il = 1.0f / lrow;
                bf16_t* orow = XA + (size_t)trow * D + h * 64;
#pragma unroll
                for (int g4 = 0; g4 < 4; ++g4) { *(u32x2*)(orow + 8 * g4 + 4 * hi5) = (u32x2){pk2(o0[4 * g4] * il, o0[4 * g4 + 1] * il), pk2(o0[4 * g4 + 2] * il, o0[4 * g4 + 3] * il)};
                    *(u32x2*)(orow + 32 + 8 * g4 + 4 * hi5) = (u32x2){pk2(o1[4 * g4] * il, o1[4 * g4 + 1] * il), pk2(o1[4 * g4 + 2] * il, o1[4 * g4 + 3] * il)}; }
            }
        }
        __syncthreads();
        for (int u = blk; u < 256; u += G) mem_attn_unit(u, 1, (const bf16_t*)(ws + WS_PROJ1), D, KVL + QL);
        SEAM(13);
    }
    if (IN(14)) {
        pg8::Gemm g{XA, (const bf16_t*)(ws + WS_WOUT) + (size_t)D * D, D, D, D}; pg8::StaticOrder S; S.init(T, D, G, blk);
        pg8::EpiBf16Res<true> E{XR, XR, D};
        pg8::gemm_phase<pg8::EpiBf16Res<true>, pg8::StaticOrder, false>(lds, g, S, E, nullptr);
        SEAM(14);
    }
    if (IN(15)) { route_phase(1, rsbase + 3 * T); SEAM(15); }
    if (IN(16)) { moe_gateup(1, rsbase + 3 * T); SEAM(16); }
    if (IN(17)) { moe_down(1); SEAM(17); }
    if (IN(18)) { combine_phase(1, nullptr); }
#undef IN
#undef SEAM
}

#ifndef MK_FUSED
#define MK_FUSED 1
#endif
#ifndef MK_LAST_PHASE
#define MK_LAST_PHASE NPHASE
#endif
extern "C" void kernel_launch(void* const* d_in, const int* in_sizes, int n_in, void* d_out, int out_size, void* d_ws, size_t ws_size, hipStream_t stream) {
    static int grid = 0;
    if (grid == 0) {
        if (n_in != 27 || out_size != T * D || ws_size < WS_END) { fprintf(stderr, "kernel_launch: unexpected shapes (n_in %d out %d ws %zu)\n", n_in, out_size, ws_size); grid = -1; return; }
        int dev = 0, cus = 0, per_cu = 0;
        if (hipGetDevice(&dev) != hipSuccess || hipDeviceGetAttribute(&cus, hipDeviceAttributeMultiprocessorCount, dev) != hipSuccess) { grid = -1; return; }
        if (hipFuncSetAttribute((const void*)fwd_kernel, hipFuncAttributeMaxDynamicSharedMemorySize, LDS_BYTES) != hipSuccess) { fprintf(stderr, "kernel_launch: hipFuncSetAttribute failed\n"); grid = -1; return; }
        if (hipOccupancyMaxActiveBlocksPerMultiprocessor(&per_cu, (const void*)fwd_kernel, 512, LDS_BYTES) != hipSuccess || per_cu < 1) { fprintf(stderr, "kernel_launch: occupancy query says %d\n", per_cu); (void)hipGetLastError(); per_cu = 1; }
        grid = cus;
    }
    if (grid < 0) return;
    (void)hipMemsetAsync((char*)d_ws + WS_CTL, 0, CTL_ZERO_BYTES, stream);
    Args a{};
    for (int i = 0; i < 27; ++i) a.in[i] = d_in[i];
    a.out = (float*)d_out; a.ws = (unsigned char*)d_ws;
#if MK_FUSED
    a.ph_lo = 0; a.ph_hi = MK_LAST_PHASE;
    hipLaunchKernelGGL(fwd_kernel, dim3(grid), dim3(512), LDS_BYTES, stream, a);
#else
    for (int ph = 0; ph < MK_LAST_PHASE; ++ph) { a.ph_lo = ph; a.ph_hi = ph + 1; hipLaunchKernelGGL(fwd_kernel, dim3(grid), dim3(512), LDS_BYTES, stream, a); }
#endif
}
```
